# Optimizing an MI355X kernel written in HIP

```python
import math
import jax, jax.numpy as jnp
from jax import lax
import numpy as np

D_MODEL = 1024
BATCH = 8
SEQ = 4096
DEPTH = 4

N_MIXERS = 4
N_RET = (DEPTH + 3) // 4
N_CONV = (DEPTH + 2) // 4
N_NSA = (DEPTH + 1) // 4
N_POOL = DEPTH // 4

ROPE_THETA = 10000.0
DN_ALPHA = (2.0 * DEPTH) ** 0.25
DN_BETA = (8.0 * DEPTH) ** -0.25
LN_EPS = 1e-5
NEG = -1e30

RET_HEADS = 4
RET_DK = D_MODEL // RET_HEADS
RET_DV = 2 * D_MODEL // RET_HEADS
RET_CHUNK = 128

CONV_WIDTH = 31

NSA_HEADS = 16
NSA_KV_GROUPS = 2
NSA_HEAD_DIM = D_MODEL // NSA_HEADS
NSA_CMP_BLOCK = 32
NSA_CMP_STRIDE = 16
NSA_CMP_HIDDEN = 256
NSA_SEL_BLOCK = 64
NSA_TOP_N = 16
NSA_WINDOW = 512
NSA_Q_BLOCK = 64
NSA_FORCE = 1e6
NSA_IN_WIDTH = NSA_HEADS * NSA_HEAD_DIM + 6 * NSA_KV_GROUPS * NSA_HEAD_DIM + 3 * NSA_HEADS

POOL_WINDOWS = (2, 4, 8, 16)
POOL_GROUP = D_MODEL // len(POOL_WINDOWS)

N_EXPERTS = 32
TOP_K = 4
D_FF = D_MODEL
SWIGLU_LIMIT = 7.0
SWIGLU_ALPHA = 1.702
MOE_BLOCK = 256

kernel_name = 'hybrid_ret_conv_nsa_pool_moe_trunk'


def layer_norm(x, g, b):
    xf = x.astype(jnp.float32)
    mu = xf.mean(-1, keepdims=True)
    var = jnp.square(xf - mu).mean(-1, keepdims=True)
    return ((xf - mu) * lax.rsqrt(var + LN_EPS)).astype(x.dtype) * g + b


def rope(x, positions):
    d = x.shape[-1]
    inv = ROPE_THETA ** (-jnp.arange(0, d, 2, dtype=jnp.float32) / d)
    ang = positions.astype(jnp.float32)[:, :, None, None] * inv
    cos, sin = jnp.cos(ang).astype(x.dtype), jnp.sin(ang).astype(x.dtype)
    x1, x2 = x[..., : d // 2], x[..., d // 2:]
    return jnp.concatenate([x1 * cos - x2 * sin, x1 * sin + x2 * cos], axis=-1)


def retention_mixer(h, positions, w_in, gn_g, gn_b, w_out):
    B, S, _ = h.shape
    H, dk, dv, C = RET_HEADS, RET_DK, RET_DV, RET_CHUNK
    n = S // C
    dt = h.dtype
    q, k, v, g = jnp.split(h @ w_in, [H * dk, 2 * H * dk, 2 * H * dk + H * dv], axis=-1)
    q = rope(q.reshape(B, S, H, dk), positions)
    k = rope(k.reshape(B, S, H, dk), positions) * (dk ** -0.5)
    v = v.reshape(B, S, H, dv)
    log_gamma = jnp.log1p(-(2.0 ** (-5.0 - jnp.arange(H, dtype=jnp.float32))))
    i = jnp.arange(C, dtype=jnp.float32)
    rel = i[:, None] - i[None, :]
    decay_intra = jnp.where(rel >= 0, jnp.exp(log_gamma[:, None, None] * jnp.maximum(rel, 0.0)), 0.0).astype(dt)
    decay_q = jnp.exp(log_gamma[:, None] * (i + 1.0)).astype(dt)[..., None]
    decay_k = jnp.exp(log_gamma[:, None] * (C - 1.0 - i)).astype(dt)[..., None]
    decay_chunk = jnp.exp(log_gamma * C).astype(dt)[:, None, None]

    def chunks(t):
        return t.reshape(B, n, C, H, t.shape[-1]).transpose(1, 0, 3, 2, 4)

    def step(state, qkv):
        qc, kc, vc = qkv
        o = jnp.einsum('bhij,bhjv->bhiv', jnp.einsum('bhid,bhjd->bhij', qc, kc) * decay_intra, vc)
        o = o + jnp.einsum('bhid,bhdv->bhiv', qc * decay_q, state)
        state = state * decay_chunk + jnp.einsum('bhjd,bhjv->bhdv', kc * decay_k, vc)
        return state, o

    _, o = lax.scan(step, jnp.zeros((B, H, dk, dv), dt), (chunks(q), chunks(k), chunks(v)))
    o = o.transpose(1, 0, 3, 2, 4).reshape(B, S, H, dv)
    of = o.astype(jnp.float32)
    mu = of.mean(-1, keepdims=True)
    var = jnp.square(of - mu).mean(-1, keepdims=True)
    o = ((of - mu) * lax.rsqrt(var + LN_EPS)).astype(dt).reshape(B, S, H * dv) * gn_g + gn_b
    return (jax.nn.silu(g) * o) @ w_out


def conv_mixer(h, w_pw1, b_pw1, w_dw, b_dw, ln_g, ln_b, w_pw2, b_pw2):
    a, gate = jnp.split(h @ w_pw1 + b_pw1, 2, axis=-1)
    u = a * jax.nn.sigmoid(gate)
    u = jnp.pad(u, ((0, 0), (CONV_WIDTH - 1, 0), (0, 0)))
    u = lax.conv_general_dilated(u, w_dw[:, None, :], window_strides=(1,), padding='VALID',
                                 dimension_numbers=('NWC', 'WIO', 'NWC'),
                                 feature_group_count=D_MODEL) + b_dw
    u = jax.nn.silu(layer_norm(u, ln_g, ln_b))
    return u @ w_pw2 + b_pw2


def _compress(t, pos_emb, w1, w2, win_idx):
    blk = t[:, win_idx] + pos_emb[:, None, :]
    b_, n, l, g_, d = blk.shape
    blk = blk.transpose(0, 3, 1, 2, 4).reshape(b_, g_, n, l * d)
    return jax.nn.gelu(blk @ w1) @ w2


def nsa_mixer(h, positions, w_in, gate_b, cmp_pos_k, cmp_pos_v, cmp_k_w1, cmp_k_w2,
              cmp_v_w1, cmp_v_w2, w_out):
    B, S, _ = h.shape
    H, G, dh = NSA_HEADS, NSA_KV_GROUPS, NSA_HEAD_DIM
    R = H // G
    Qb, W, ls = NSA_Q_BLOCK, NSA_WINDOW, NSA_SEL_BLOCK
    dt = h.dtype
    sizes = [H * dh] + [G * dh] * 6 + [3 * H]
    q, kc, vc, ks, vs, kw, vw, gl = jnp.split(h @ w_in, np.cumsum(sizes)[:-1].tolist(), axis=-1)
    q = rope(q.reshape(B, S, H, dh), positions) * (dh ** -0.5)
    kc = rope(kc.reshape(B, S, G, dh), positions)
    ks = rope(ks.reshape(B, S, G, dh), positions)
    kw = rope(kw.reshape(B, S, G, dh), positions)
    vc, vs, vw = (t.reshape(B, S, G, dh) for t in (vc, vs, vw))
    gates = jax.nn.sigmoid(gl + gate_b).reshape(B, S, H, 3)

    n_cmp = (S - NSA_CMP_BLOCK) // NSA_CMP_STRIDE + 1
    cmp_start = np.arange(n_cmp) * NSA_CMP_STRIDE
    win_idx = cmp_start[:, None] + np.arange(NSA_CMP_BLOCK)[None, :]
    k_cmp = _compress(kc, cmp_pos_k, cmp_k_w1, cmp_k_w2, win_idx)
    v_cmp = _compress(vc, cmp_pos_v, cmp_v_w1, cmp_v_w2, win_idx)
    cmp_end = jnp.asarray(cmp_start + NSA_CMP_BLOCK - 1)
    n_sel = S // ls
    j_np = np.arange(n_sel)
    overlap = jnp.asarray(((cmp_start[:, None] < (j_np[None, :] + 1) * ls) &
                           (cmp_start[:, None] + NSA_CMP_BLOCK > j_np[None, :] * ls)).astype(np.float32))
    k_sel_n = min(NSA_TOP_N, n_sel)
    ks_blocks = ks.reshape(B, n_sel, ls, G, dh).transpose(0, 3, 1, 2, 4)
    vs_blocks = vs.reshape(B, n_sel, ls, G, dh).transpose(0, 3, 1, 2, 4)
    kw_pad = jnp.pad(kw, ((0, 0), (W, 0), (0, 0), (0, 0)))
    vw_pad = jnp.pad(vw, ((0, 0), (W, 0), (0, 0), (0, 0)))
    b_ix = jnp.arange(B)[:, None, None, None]
    g_ix = jnp.arange(G)[None, :, None, None]
    j = jnp.arange(n_sel)

    def q_block(qb):
        t0 = qb * Qb
        t = t0 + jnp.arange(Qb)
        qi = lax.dynamic_slice_in_dim(q, t0, Qb, axis=1).reshape(B, Qb, G, R, dh)
        s_c = jnp.einsum('bqgrd,bgnd->bgrqn', qi, k_cmp).astype(jnp.float32)
        mask_c = cmp_end[None, :] <= t[:, None]
        p_c = jnp.where(mask_c, jax.nn.softmax(jnp.where(mask_c, s_c, NEG), axis=-1), 0.0)
        o_c = jnp.einsum('bgrqn,bgnd->bqgrd', p_c.astype(dt), v_cmp)
        imp = jnp.einsum('bgrqn,nj->bgqj', p_c, overlap)
        cur = t // ls
        forced = (j[None, :] == 0) | (j[None, :] == cur[:, None]) | (j[None, :] == cur[:, None] - 1)
        score = jnp.where(j[None, :] * ls <= t[:, None], jnp.where(forced, NSA_FORCE, imp), NEG)
        top_s, top_i = lax.top_k(score, k_sel_n)
        k_g = ks_blocks[b_ix, g_ix, top_i]
        v_g = vs_blocks[b_ix, g_ix, top_i]
        key_pos = top_i[..., None] * ls + jnp.arange(ls)
        mask_s = (top_s > 0.5 * NEG)[..., None] & (key_pos <= t[None, None, :, None, None])
        s_s = jnp.einsum('bqgrd,bgqnld->bgrqnl', qi, k_g).astype(jnp.float32)
        s_s = jnp.where(mask_s[:, :, None], s_s, NEG)
        p_s = jax.nn.softmax(s_s.reshape(B, G, R, Qb, k_sel_n * ls), axis=-1).reshape(s_s.shape)
        o_s = jnp.einsum('bgrqnl,bgqnld->bqgrd', p_s.astype(dt), v_g)
        kwin = lax.dynamic_slice_in_dim(kw_pad, t0, Qb + W, axis=1)
        vwin = lax.dynamic_slice_in_dim(vw_pad, t0, Qb + W, axis=1)
        kpos = t0 - W + jnp.arange(Qb + W)
        mask_w = (kpos[None, :] <= t[:, None]) & (kpos[None, :] > t[:, None] - W) & (kpos[None, :] >= 0)
        s_w = jnp.einsum('bqgrd,bkgd->bgrqk', qi, kwin).astype(jnp.float32)
        p_w = jax.nn.softmax(jnp.where(mask_w, s_w, NEG), axis=-1)
        o_w = jnp.einsum('bgrqk,bkgd->bqgrd', p_w.astype(dt), vwin)
        gt = lax.dynamic_slice_in_dim(gates, t0, Qb, axis=1).reshape(B, Qb, G, R, 3)
        o = gt[..., 0:1] * o_c + gt[..., 1:2] * o_s + gt[..., 2:3] * o_w
        return o.reshape(B, Qb, H * dh)

    out = lax.map(q_block, jnp.arange(S // Qb))
    out = out.transpose(1, 0, 2, 3).reshape(B, S, H * dh)
    return out @ w_out


def pool_mixer(h, w, b, scale):
    B, S, D = h.shape
    cs = jnp.pad(jnp.cumsum(h.astype(jnp.float32), axis=1), ((0, 0), (1, 0), (0, 0)))
    t = jnp.arange(S)
    groups = []
    for gi, win in enumerate(POOL_WINDOWS):
        sl = slice(gi * POOL_GROUP, (gi + 1) * POOL_GROUP)
        lo = jnp.maximum(t + 1 - win, 0)
        cnt = (t + 1 - lo).astype(jnp.float32)[None, :, None]
        groups.append((cs[:, 1:, sl] - cs[:, lo, sl]) / cnt)
    pooled = jnp.concatenate(groups, axis=-1).astype(h.dtype) - h
    y = jnp.einsum('bsgc,gcd->bsgd', pooled.reshape(B, S, len(POOL_WINDOWS), POOL_GROUP), w)
    return (y.reshape(B, S, D) + b) * scale


def moe(h, router_w, router_b, w1, b1, w2, b2):
    B, S, D = h.shape
    T = B * S
    xf = h.reshape(T, D)
    logits = (xf @ router_w + router_b).astype(jnp.float32)
    top_v, top_i = lax.top_k(logits, TOP_K)
    gate = jax.nn.softmax(top_v, axis=-1).astype(h.dtype)
    flat_e = top_i.reshape(-1)
    flat_tok = jnp.arange(T * TOP_K, dtype=jnp.int32) // TOP_K
    flat_w = gate.reshape(-1)
    order = jnp.argsort(flat_e)
    e_sorted = flat_e[order]
    counts = jnp.bincount(flat_e, length=N_EXPERTS)
    starts = jnp.cumsum(counts) - counts
    blocks_per = (counts + MOE_BLOCK - 1) // MOE_BLOCK
    block_end = jnp.cumsum(blocks_per)
    pad_start = (block_end - blocks_per) * MOE_BLOCK
    dest = pad_start[e_sorted] + (jnp.arange(T * TOP_K) - starts[e_sorted])
    n_blocks = -(-(T * TOP_K) // MOE_BLOCK) + N_EXPERTS
    slot_tok = jnp.full((n_blocks * MOE_BLOCK,), T, jnp.int32).at[dest].set(flat_tok[order])
    slot_w = jnp.zeros((n_blocks * MOE_BLOCK,), h.dtype).at[dest].set(flat_w[order])
    block_expert = jnp.minimum(jnp.searchsorted(block_end, jnp.arange(n_blocks), side='right'), N_EXPERTS - 1)
    x_pad = jnp.concatenate([xf, jnp.zeros((1, D), h.dtype)], axis=0)

    def expert_block(args):
        tok, e = args
        gu = x_pad[tok] @ w1[e] + b1[e]
        g_, up = gu[:, :D_FF], gu[:, D_FF:]
        g_ = jnp.minimum(g_, SWIGLU_LIMIT)
        up = jnp.clip(up, -SWIGLU_LIMIT, SWIGLU_LIMIT)
        return ((up + 1.0) * (g_ * jax.nn.sigmoid(SWIGLU_ALPHA * g_))) @ w2[e] + b2[e]

    out = lax.map(expert_block, (slot_tok.reshape(n_blocks, MOE_BLOCK), block_expert))
    y = jnp.zeros((T + 1, D), h.dtype).at[slot_tok].add(out.reshape(-1, D) * slot_w[:, None])
    return y[:T].reshape(B, S, D)


def _w(key, shape, fan_in, gain=1.0):
    return jax.random.normal(key, shape, jnp.float32) * (gain * fan_in ** -0.5)


def _gain(key, shape):
    return 1.0 + 0.02 * jax.random.normal(key, shape, jnp.float32)


def _bias(key, shape, s=0.02):
    return s * jax.random.normal(key, shape, jnp.float32)


def setup_inputs(seed: int = 0) -> dict:
    key = jax.random.key(seed)
    ks = iter(jax.random.split(key, 64))
    D, E, F = D_MODEL, N_EXPERTS, D_FF
    H, dk, dv = RET_HEADS, RET_DK, RET_DV
    Hn, G, dh = NSA_HEADS, NSA_KV_GROUPS, NSA_HEAD_DIM
    offs = jax.random.randint(next(ks), (BATCH, 1), 0, 1024, dtype=jnp.int32)
    return {
        'x': jax.random.normal(next(ks), (BATCH, SEQ, D), jnp.float32),
        'c': jax.random.normal(next(ks), (BATCH, D), jnp.float32),
        'positions': offs + jnp.arange(SEQ, dtype=jnp.int32)[None, :],
        'ada_w': _w(next(ks), (DEPTH, D, 6 * D), D, 0.2),
        'ada_b': _bias(next(ks), (DEPTH, 6 * D), 0.01),
        'ln1_g': _gain(next(ks), (DEPTH, D)),
        'ln1_b': _bias(next(ks), (DEPTH, D)),
        'ln2_g': _gain(next(ks), (DEPTH, D)),
        'ln2_b': _bias(next(ks), (DEPTH, D)),
        'router_w': _w(next(ks), (DEPTH, D, E), D),
        'router_b': _bias(next(ks), (DEPTH, E), 0.01),
        'moe_w1': _w(next(ks), (DEPTH, E, D, 2 * F), D),
        'moe_b1': _bias(next(ks), (DEPTH, E, 2 * F), 0.01),
        'moe_w2': _w(next(ks), (DEPTH, E, F, D), F, DN_BETA),
        'moe_b2': _bias(next(ks), (DEPTH, E, D), 0.01),
        'ret_w_in': _w(next(ks), (N_RET, D, 2 * H * dk + 2 * H * dv), D),
        'ret_gn_g': _gain(next(ks), (N_RET, H * dv)),
        'ret_gn_b': _bias(next(ks), (N_RET, H * dv)),
        'ret_w_out': _w(next(ks), (N_RET, H * dv, D), H * dv, DN_BETA),
        'conv_w_pw1': _w(next(ks), (N_CONV, D, 2 * D), D),
        'conv_b_pw1': _bias(next(ks), (N_CONV, 2 * D)),
        'conv_w_dw': _w(next(ks), (N_CONV, CONV_WIDTH, D), CONV_WIDTH),
        'conv_b_dw': _bias(next(ks), (N_CONV, D)),
        'conv_ln_g': _gain(next(ks), (N_CONV, D)),
        'conv_ln_b': _bias(next(ks), (N_CONV, D)),
        'conv_w_pw2': _w(next(ks), (N_CONV, D, D), D, DN_BETA),
        'conv_b_pw2': _bias(next(ks), (N_CONV, D)),
        'nsa_w_in': _w(next(ks), (N_NSA, D, NSA_IN_WIDTH), D),
        'nsa_gate_b': _bias(next(ks), (N_NSA, 3 * Hn), 0.1),
        'nsa_cmp_pos_k': _bias(next(ks), (N_NSA, NSA_CMP_BLOCK, dh), 0.1),
        'nsa_cmp_pos_v': _bias(next(ks), (N_NSA, NSA_CMP_BLOCK, dh), 0.1),
        'nsa_cmp_k_w1': _w(next(ks), (N_NSA, NSA_CMP_BLOCK * dh, NSA_CMP_HIDDEN), NSA_CMP_BLOCK * dh),
        'nsa_cmp_k_w2': _w(next(ks), (N_NSA, NSA_CMP_HIDDEN, dh), NSA_CMP_HIDDEN),
        'nsa_cmp_v_w1': _w(next(ks), (N_NSA, NSA_CMP_BLOCK * dh, NSA_CMP_HIDDEN), NSA_CMP_BLOCK * dh),
        'nsa_cmp_v_w2': _w(next(ks), (N_NSA, NSA_CMP_HIDDEN, dh), NSA_CMP_HIDDEN),
        'nsa_w_out': _w(next(ks), (N_NSA, Hn * dh, D), Hn * dh, DN_BETA),
        'pool_w': _w(next(ks), (N_POOL, len(POOL_WINDOWS), POOL_GROUP, POOL_GROUP), POOL_GROUP, DN_BETA),
        'pool_b': _bias(next(ks), (N_POOL, D)),
        'pool_scale': _gain(next(ks), (N_POOL, D)),
    }


def reference(x, c, positions, ada_w, ada_b, ln1_g, ln1_b, ln2_g, ln2_b, router_w, router_b,
              moe_w1, moe_b1, moe_w2, moe_b2, ret_w_in, ret_gn_g, ret_gn_b, ret_w_out,
              conv_w_pw1, conv_b_pw1, conv_w_dw, conv_b_dw, conv_ln_g, conv_ln_b, conv_w_pw2,
              conv_b_pw2, nsa_w_in, nsa_gate_b, nsa_cmp_pos_k, nsa_cmp_pos_v, nsa_cmp_k_w1,
              nsa_cmp_k_w2, nsa_cmp_v_w1, nsa_cmp_v_w2, nsa_w_out, pool_w, pool_b, pool_scale):
    c_act = jax.nn.silu(c)
    for i in range(DEPTH):
        kind, j = i % N_MIXERS, i // N_MIXERS
        mod = c_act @ ada_w[i] + ada_b[i]
        sh1, sc1, g1, sh2, sc2, g2 = (m[:, None, :] for m in jnp.split(mod, 6, axis=-1))
        h = x * (1.0 + sc1) + sh1
        if kind == 0:
            y = retention_mixer(h, positions, ret_w_in[j], ret_gn_g[j], ret_gn_b[j], ret_w_out[j])
        elif kind == 1:
            y = conv_mixer(h, conv_w_pw1[j], conv_b_pw1[j], conv_w_dw[j], conv_b_dw[j],
                           conv_ln_g[j], conv_ln_b[j], conv_w_pw2[j], conv_b_pw2[j])
        elif kind == 2:
            y = nsa_mixer(h, positions, nsa_w_in[j], nsa_gate_b[j], nsa_cmp_pos_k[j], nsa_cmp_pos_v[j],
                          nsa_cmp_k_w1[j], nsa_cmp_k_w2[j], nsa_cmp_v_w1[j], nsa_cmp_v_w2[j], nsa_w_out[j])
        else:
            y = pool_mixer(h, pool_w[j], pool_b[j], pool_scale[j])
        x = layer_norm(DN_ALPHA * x + (1.0 + g1) * y, ln1_g[i], ln1_b[i])
        h = x * (1.0 + sc2) + sh2
        y = moe(h, router_w[i], router_b[i], moe_w1[i], moe_b1[i], moe_w2[i], moe_b2[i])
        x = layer_norm(DN_ALPHA * x + (1.0 + g2) * y, ln2_g[i], ln2_b[i])
    return x
```

```cpp
#ifndef HOSTTEST
#include <hip/hip_runtime.h>
#include <cstdio>
#define HD __host__ __device__ __forceinline__
#else
#include <cmath>
#include <cstring>
#include <cstdio>
#include <cstdlib>
#define HD inline
#endif
#include <cstdint>
#include <cstddef>

#ifndef PROBE_KIND
#define PROBE_KIND 0
#endif
#ifndef CFG_BATCH
#define CFG_BATCH 8
#endif
#ifndef CFG_SEQ
#define CFG_SEQ 4096
#endif
constexpr int NB = CFG_BATCH, S_ = CFG_SEQ, T_ = NB * S_, D_ = 1024, DEPTH = 4;
constexpr float DN_ALPHA = 1.6817928305074290f;
constexpr float LN_EPS = 1e-5f;
constexpr int RH = 4, RDK = 256, RDV = 512, RCH = 128, RNCH = S_ / RCH, RW = 2 * RH * RDK + 2 * RH * RDV;
constexpr int CW = 31;
constexpr int NH = 16, NG = 2, NDH = 64, NR = NH / NG, NCMP = (S_ - 32) / 16 + 1, NSEL = S_ / 64, KSEL = NSEL < 16 ? NSEL : 16, NWIN = 512;
constexpr int NKVW = 768, NINW = 1840, NBG = NB * NG;
constexpr int NE = 32, TOPK = 4, DFF = 1024;
constexpr float SW_LIMIT = 7.0f, SW_ALPHA = 1.702f;

typedef unsigned short bf16;
typedef unsigned long long u64;

HD unsigned f32_bits(float f) { unsigned u; __builtin_memcpy(&u, &f, 4); return u; }
HD float bits_f32(unsigned u) { float f; __builtin_memcpy(&f, &u, 4); return f; }
HD float bf2f(bf16 v) { return bits_f32((unsigned)v << 16); }
HD bf16 f2bf(float f) { unsigned u = f32_bits(f); return (bf16)((u + 0x7fffu + ((u >> 16) & 1u)) >> 16); }
HD float bfr(float f) { return bf2f(f2bf(f)); }
HD float sigmoidf_(float x) { return 1.0f / (1.0f + expf(-x)); }
HD float siluf_(float x) { return x * sigmoidf_(x); }
HD float gelu_tanh(float x) { return 0.5f * x * (1.0f + tanhf(0.7978845608028654f * (x + 0.044715f * x * x * x))); }
HD void sincos_acc(float x, float& s, float& c) {
    const double xd = (double)x; const double kq = rint(xd * 0.6366197723675814);
    const double y = xd - kq * 1.5707963267948966; const int q = (int)((long long)kq & 3);
    const float yf = (float)y, z = yf * yf;
    const float sp = yf + yf * z * (-1.6666654611e-1f + z * (8.3321608736e-3f + z * (-1.9515295891e-4f)));
    const float cp = 1.0f - 0.5f * z + z * z * (4.166664568298827e-2f + z * (-1.388731625493765e-3f + z * 2.443315711809948e-5f));
    if (q == 0) { s = sp; c = cp; } else if (q == 1) { s = cp; c = -sp; } else if (q == 2) { s = -sp; c = -cp; } else { s = -cp; c = sp; }
}

enum InIdx { I_X = 0, I_C, I_POS, I_ADA_W, I_ADA_B, I_LN1_G, I_LN1_B, I_LN2_G, I_LN2_B, I_ROUTER_W, I_ROUTER_B, I_MOE_W1, I_MOE_B1, I_MOE_W2, I_MOE_B2,
             I_RET_W_IN, I_RET_GN_G, I_RET_GN_B, I_RET_W_OUT, I_CONV_W_PW1, I_CONV_B_PW1, I_CONV_W_DW, I_CONV_B_DW, I_CONV_LN_G, I_CONV_LN_B, I_CONV_W_PW2, I_CONV_B_PW2,
             I_NSA_W_IN, I_NSA_GATE_B, I_NSA_POS_K, I_NSA_POS_V, I_NSA_K_W1, I_NSA_K_W2, I_NSA_V_W1, I_NSA_V_W2, I_NSA_W_OUT, I_POOL_W, I_POOL_B, I_POOL_SCALE, N_IN };

constexpr size_t al256(size_t x) { return (x + 255) & ~(size_t)255; }
constexpr size_t cmax(size_t a, size_t b) { return a > b ? a : b; }
constexpr size_t WS_CTL = 0, CTL_BYTES = 1u << 20, CTL_ZERO_BYTES = 32768;
constexpr size_t WS_MOD = WS_CTL + CTL_BYTES;
constexpr size_t WS_COS256 = al256(WS_MOD + (size_t)DEPTH * NB * 6 * D_ * 4);
constexpr size_t WS_SIN256 = al256(WS_COS256 + (size_t)T_ * 128 * 4);
constexpr size_t WS_COS64 = al256(WS_SIN256 + (size_t)T_ * 128 * 4);
constexpr size_t WS_SIN64 = al256(WS_COS64 + (size_t)T_ * 32 * 4);
constexpr size_t WS_CB = al256(WS_SIN64 + (size_t)T_ * 32 * 4);
constexpr size_t WS_H = al256(WS_CB + 2 * 256 * 4);
constexpr size_t WS_Y = al256(WS_H + (size_t)T_ * D_ * 2);
constexpr size_t WS_TOPW = al256(WS_Y + (size_t)T_ * D_ * 2);
constexpr size_t WS_LIST = al256(WS_TOPW + (size_t)T_ * 4 * 4);
constexpr size_t WS_MOE = al256(WS_LIST + (size_t)NE * T_ * 4);
constexpr size_t WS_ACT = WS_MOE;
constexpr size_t WS_YS = al256(WS_ACT + (size_t)T_ * 4 * DFF * 2);
constexpr size_t WS_GU = al256(WS_YS + (size_t)T_ * 4 * D_ * 2);
constexpr size_t MOE_ROWS = (size_t)T_ * 4 + NE * 256;
constexpr size_t WS_ACTC = WS_MOE;
constexpr size_t WS_YC = al256(WS_ACTC + MOE_ROWS * DFF * 2);
constexpr size_t WS_EP = al256(WS_YC + MOE_ROWS * D_ * 2);
constexpr size_t WS_H8 = al256(WS_EP + (size_t)T_ * 16);
static_assert(WS_H8 + (size_t)T_ * D_ <= WS_GU + (size_t)T_ * 4 * 2 * DFF * 2, "compact MoE buffers fit the naive region");
constexpr size_t WS_MX = al256(WS_GU + (size_t)T_ * 4 * 2 * DFF * 2);
constexpr size_t WS_QKVG = WS_MX;
constexpr size_t WS_RO = al256(WS_QKVG + (size_t)T_ * RW * 2);
constexpr size_t WS_RA2 = al256(WS_RO + (size_t)T_ * RH * RDV * 2);
constexpr size_t WS_RP = al256(WS_RA2 + (size_t)T_ * RH * RDV * 2);
constexpr size_t WS_RST = al256(WS_RP + (size_t)T_ * RH * RCH * 4);
constexpr size_t WS_KT = WS_RP;
constexpr size_t WS_VT = al256(WS_KT + (size_t)RH * RDK * T_ * 2);
constexpr size_t WS_RET_END = cmax(al256(WS_RST + (size_t)(RNCH - 1) * NB * RH * RDK * RDV * 4), al256(WS_VT + (size_t)RH * RDV * T_ * 2));
constexpr size_t WS_CRAW = WS_MX;
constexpr size_t WS_CU = al256(WS_CRAW + (size_t)T_ * 2 * D_ * 2);
constexpr size_t WS_CCV = al256(WS_CU + (size_t)T_ * D_ * 2);
constexpr size_t WS_CA2 = al256(WS_CCV + (size_t)T_ * D_ * 4);
constexpr size_t WS_CONV_END = al256(WS_CA2 + (size_t)T_ * D_ * 2);
constexpr size_t WS_NQ = WS_MX;
constexpr size_t WS_NKV = al256(WS_NQ + (size_t)T_ * D_ * 2);
constexpr size_t WS_NGT = al256(WS_NKV + (size_t)(T_ + 64) * NKVW * 2);
constexpr size_t WS_CMPH = al256(WS_NGT + (size_t)T_ * 48 * 4);
constexpr size_t WS_CMPKV = al256(WS_CMPH + (size_t)2 * NBG * 256 * 256 * 2);
constexpr size_t WS_SELM = al256(WS_CMPKV + (size_t)2 * NBG * 256 * 64 * 2);
constexpr size_t WS_NO = al256(WS_SELM + (size_t)T_ * 2 * 8);
constexpr size_t WS_OC = al256(WS_NO + (size_t)T_ * D_ * 2);
constexpr size_t WS_IMP = al256(WS_OC + (size_t)T_ * D_ * 4);
constexpr size_t WS_PC = al256(WS_IMP + (size_t)T_ * 2 * 64 * 4);
constexpr size_t WS_NSA_END = al256(WS_PC + (size_t)T_ * 16 * 256 * 4);
constexpr size_t WS_PL = WS_MX;
constexpr size_t WS_POOL_END = al256(WS_PL + (size_t)T_ * D_ * 2);
constexpr size_t WS_MIX_END = cmax(cmax(WS_RET_END, WS_CONV_END), cmax(WS_NSA_END, WS_POOL_END));
constexpr size_t WS_W1T = WS_MIX_END;
constexpr size_t WS_W2T = al256(WS_W1T + (size_t)DEPTH * NE * 2 * DFF * D_ * 2);
constexpr size_t WS_RWIN = al256(WS_W2T + (size_t)DEPTH * NE * D_ * DFF * 2);
constexpr size_t WS_RWOUT = al256(WS_RWIN + (size_t)RW * D_ * 2);
constexpr size_t WS_CPW1 = al256(WS_RWOUT + (size_t)D_ * 2048 * 2);
constexpr size_t WS_CPW2 = al256(WS_CPW1 + (size_t)2048 * D_ * 2);
constexpr size_t WS_NWIN = al256(WS_CPW2 + (size_t)D_ * D_ * 2);
constexpr size_t WS_NWOUT = al256(WS_NWIN + (size_t)2048 * D_ * 2);
constexpr size_t WS_CW1T = al256(WS_NWOUT + (size_t)D_ * D_ * 2);
constexpr size_t WS_PWT = al256(WS_CW1T + (size_t)2 * 256 * 2048 * 2);
constexpr size_t WS_COS256T = al256(WS_PWT + (size_t)4 * 256 * 256 * 2);
constexpr size_t WS_SIN256T = al256(WS_COS256T + (size_t)128 * T_ * 4);
constexpr size_t WS_XB = al256(WS_SIN256T + (size_t)128 * T_ * 4);
constexpr size_t WS_END = al256(WS_XB + (size_t)T_ * D_ * 2);

constexpr int CW_CNT = 64;
constexpr int CW_BAR = 4096;

struct Ctx {
    const void* in[N_IN];
    float* out;
    unsigned char* ws;
    int ph_lo, ph_hi;
    HD const float* f(int i) const { return (const float*)in[i]; }
    HD const int* pos() const { return (const int*)in[I_POS]; }
    template <class Tp> HD Tp* w(size_t off) const { return (Tp*)(ws + off); }
    HD float* mod(int l, int b, int part) const { return w<float>(WS_MOD) + ((size_t)(l * NB + b) * 6 + part) * D_; }
    HD int* cnt(int l) const { return w<int>(WS_CTL) + CW_CNT + l * NE; }
};

#ifdef HOSTTEST
#define ATOMIC_ADD_I32(p, v) __atomic_fetch_add((p), (v), __ATOMIC_RELAXED)
#else
#define ATOMIC_ADD_I32(p, v) atomicAdd((p), (v))
#endif


HD void ph_prologue(const Ctx& C, long gt, long gs) {
    for (long it = gt; it < (long)DEPTH * 6 * D_; it += gs) {
        const int l = (int)(it / (6 * D_)), j = (int)(it % (6 * D_));
        float acc[NB];
#pragma unroll
        for (int b = 0; b < NB; ++b) acc[b] = 0.f;
        const float* W = C.f(I_ADA_W) + (size_t)l * D_ * 6 * D_ + j;
        const float* cc = C.f(I_C);
        for (int k = 0; k < D_; ++k) {
            const float wv = W[(size_t)k * 6 * D_];
#pragma unroll
            for (int b = 0; b < NB; ++b) acc[b] += siluf_(cc[b * D_ + k]) * wv;
        }
        const float bias = C.f(I_ADA_B)[l * 6 * D_ + j];
#pragma unroll
        for (int b = 0; b < NB; ++b) C.w<float>(WS_MOD)[(size_t)(l * NB + b) * 6 * D_ + j] = acc[b] + bias;
    }
    for (long it = gt; it < (long)T_ * 128; it += gs) {
        const int t = (int)(it >> 7), i = (int)(it & 127);
        const float inv = exp2f(-(float)(2 * i) / 256.0f * 13.287712379549449f);
        const float ang = (float)C.pos()[t] * inv; float s, c; sincos_acc(ang, s, c);
        C.w<float>(WS_COS256)[it] = c; C.w<float>(WS_SIN256)[it] = s;
    }
    for (long it = gt; it < (long)T_ * 32; it += gs) {
        const int t = (int)(it >> 5), i = (int)(it & 31);
        const float inv = exp2f(-(float)(2 * i) / 64.0f * 13.287712379549449f);
        const float ang = (float)C.pos()[t] * inv; float s, c; sincos_acc(ang, s, c);
        C.w<float>(WS_COS64)[it] = c; C.w<float>(WS_SIN64)[it] = s;
    }
    for (long it = gt; it < 512; it += gs) {
        const int tz = (int)(it >> 8), j = (int)(it & 255);
        const float* pe = C.f(tz ? I_NSA_POS_V : I_NSA_POS_K); const float* w1 = C.f(tz ? I_NSA_V_W1 : I_NSA_K_W1);
        float a = 0.f;
        for (int i = 0; i < 2048; ++i) a += pe[i] * w1[(size_t)i * 256 + j];
        C.w<float>(WS_CB)[it] = a;
    }
}

HD void ph_modx0(const Ctx& C, long gt, long gs) {
    const float* x = C.f(I_X);
    for (long it = gt; it < (long)T_ * D_; it += gs) {
        const int t = (int)(it / D_), c = (int)(it % D_), b = t / S_;
        C.w<bf16>(WS_H)[it] = f2bf(x[it] * (1.0f + C.mod(0, b, 1)[c]) + C.mod(0, b, 0)[c]);
    }
}

HD void ph_ln(const Ctx& C, int l, int which, long gt, long gs) {
    const float* xsrc = (l == 0 && which == 0) ? C.f(I_X) : C.out;
    const float* lg = C.f(which ? I_LN2_G : I_LN1_G) + l * D_; const float* lb = C.f(which ? I_LN2_B : I_LN1_B) + l * D_;
    for (long t = gt; t < T_; t += gs) {
        const int b = (int)(t / S_);
        const float* xr = xsrc + (size_t)t * D_;
        const float* gate = C.mod(l, b, which ? 5 : 2);
        const bf16* y0 = which ? C.w<bf16>(WS_YS) + (size_t)t * 4 * D_ : C.w<bf16>(WS_Y) + (size_t)t * D_;
        float w0 = 1.f, w1 = 0.f, w2 = 0.f, w3 = 0.f;
        if (which) { const float* tw = C.w<float>(WS_TOPW) + (size_t)t * 4; w0 = tw[0]; w1 = tw[1]; w2 = tw[2]; w3 = tw[3]; }
#define LN_V(c) (DN_ALPHA * xr[c] + (1.0f + gate[c]) * (which ? (w0 * bf2f(y0[c]) + w1 * bf2f(y0[D_ + (c)]) + w2 * bf2f(y0[2 * D_ + (c)]) + w3 * bf2f(y0[3 * D_ + (c)])) : bf2f(y0[c])))
        float s = 0.f;
        for (int c = 0; c < D_; ++c) s += LN_V(c);
        const float mu = s * (1.0f / D_);
        float q = 0.f;
        for (int c = 0; c < D_; ++c) { const float d = LN_V(c) - mu; q += d * d; }
        const float rstd = 1.0f / sqrtf(q * (1.0f / D_) + LN_EPS);
        const bool has_next = which == 0 || l + 1 < DEPTH;
        const int nl = which ? l + 1 : l;
        const float* sh = has_next ? C.mod(nl, b, which ? 0 : 3) : nullptr; const float* sc = has_next ? C.mod(nl, b, which ? 1 : 4) : nullptr;
        float lgt[NE];
#pragma unroll
        for (int e = 0; e < NE; ++e) lgt[e] = 0.f;
        const float* rw = C.f(I_ROUTER_W) + (size_t)l * D_ * NE;
        float* xo = C.out + (size_t)t * D_; bf16* ho = C.w<bf16>(WS_H) + (size_t)t * D_;
        for (int c = 0; c < D_; ++c) {
            const float xn = (LN_V(c) - mu) * rstd * lg[c] + lb[c];
            xo[c] = xn;
            if (has_next) {
                const float h = xn * (1.0f + sc[c]) + sh[c];
                ho[c] = f2bf(h);
                if (which == 0) {
#pragma unroll
                    for (int e = 0; e < NE; ++e) lgt[e] += h * rw[c * NE + e];
                }
            }
        }
#undef LN_V
        if (which == 0) {
            const float* rb = C.f(I_ROUTER_B) + l * NE;
#pragma unroll
            for (int e = 0; e < NE; ++e) lgt[e] += rb[e];
            int ti[4]; float tv[4];
#pragma unroll
            for (int kk = 0; kk < 4; ++kk) {
                float best = -3.0e38f; int bi = 0;
#pragma unroll
                for (int e = 0; e < NE; ++e) if (lgt[e] > best) { best = lgt[e]; bi = e; }
                tv[kk] = best; ti[kk] = bi;
#pragma unroll
                for (int e = 0; e < NE; ++e) if (e == bi) lgt[e] = -3.3e38f;
            }
            const float e1 = expf(tv[1] - tv[0]), e2 = expf(tv[2] - tv[0]), e3 = expf(tv[3] - tv[0]);
            const float inv = 1.0f / (1.0f + e1 + e2 + e3);
            float* tw = C.w<float>(WS_TOPW) + (size_t)t * 4;
            tw[0] = inv; tw[1] = e1 * inv; tw[2] = e2 * inv; tw[3] = e3 * inv;
#pragma unroll
            for (int kk = 0; kk < 4; ++kk) {
                const int p = ATOMIC_ADD_I32(C.cnt(l) + ti[kk], 1);
                C.w<int>(WS_LIST)[(size_t)ti[kk] * T_ + p] = (int)t * 4 + kk;
            }
        }
    }
}

HD void ph_moe_act(const Ctx& C, long gt, long gs) {
    const bf16* gu = C.w<bf16>(WS_GU); bf16* act = C.w<bf16>(WS_ACT);
    for (long it = gt; it < (long)T_ * 4 * DFF; it += gs) {
        const long slot = it / DFF; const int c = (int)(it % DFF);
        float g = bf2f(gu[slot * 2 * DFF + c]), up = bf2f(gu[slot * 2 * DFF + DFF + c]);
        g = fminf(g, SW_LIMIT); up = fminf(fmaxf(up, -SW_LIMIT), SW_LIMIT);
        act[it] = f2bf((up + 1.0f) * (g * sigmoidf_(SW_ALPHA * g)));
    }
}

HD float ret_lg(int h) { return log1pf(-exp2f(-5.0f - (float)h)); }
HD void ph_ret_rope(const Ctx& C, long gt, long gs) {
    bf16* z = C.w<bf16>(WS_QKVG);
    for (long it = gt; it < (long)T_ * 2 * RH * 128; it += gs) {
        const int i = (int)(it & 127); long r = it >> 7; const int hh = (int)(r % (2 * RH)); const long t = r / (2 * RH);
        bf16* p = z + t * RW + hh * RDK;
        const float cs = C.w<float>(WS_COS256)[t * 128 + i], sn = C.w<float>(WS_SIN256)[t * 128 + i];
        const float x1 = bf2f(p[i]), x2 = bf2f(p[i + 128]); const float sc = hh >= RH ? 0.0625f : 1.0f;
        p[i] = f2bf((x1 * cs - x2 * sn) * sc); p[i + 128] = f2bf((x1 * sn + x2 * cs) * sc);
    }
}
HD void ph_ret_p(const Ctx& C, long gt, long gs) {
    const bf16* z = C.w<bf16>(WS_QKVG); float* P = C.w<float>(WS_RP);
    for (long it = gt; it < (long)T_ * RH * RCH; it += gs) {
        const int j = (int)(it % RCH); long r = it / RCH; const int h = (int)(r % RH); const long t = r / RH;
        const int i = (int)(t % RCH); float v = 0.f;
        if (j <= i) {
            const bf16* q = z + t * RW + h * RDK; const bf16* k = z + (t - i + j) * RW + RH * RDK + h * RDK;
            float a = 0.f;
            for (int d = 0; d < RDK; ++d) a += bf2f(q[d]) * bf2f(k[d]);
            v = a * expf(ret_lg(h) * (float)(i - j));
        }
        P[it] = v;
    }
}
HD void ph_ret_state(const Ctx& C, long gt, long gs) {
    const bf16* z = C.w<bf16>(WS_QKVG); float* ST = C.w<float>(WS_RST);
    for (long it = gt; it < (long)NB * RH * RDK * RDV; it += gs) {
        const int v = (int)(it % RDV); long r = it / RDV; const int d = (int)(r % RDK); r /= RDK; const int h = (int)(r % RH); const int b = (int)(r / RH);
        const float lg = ret_lg(h), dc = expf(lg * (float)RCH);
        float s = 0.f;
        for (int n = 0; n < RNCH - 1; ++n) {
            float a = 0.f;
            for (int j = 0; j < RCH; ++j) {
                const size_t row = ((size_t)b * S_ + n * RCH + j) * RW;
                a += bf2f(z[row + RH * RDK + h * RDK + d]) * expf(lg * (float)(RCH - 1 - j)) * bf2f(z[row + 2 * RH * RDK + h * RDV + v]);
            }
            s = s * dc + a;
            ST[(size_t)n * NB * RH * RDK * RDV + it] = s;
        }
    }
}
HD void ph_ret_o(const Ctx& C, long gt, long gs) {
    const bf16* z = C.w<bf16>(WS_QKVG); const float* P = C.w<float>(WS_RP); const float* ST = C.w<float>(WS_RST); bf16* O = C.w<bf16>(WS_RO);
    for (long it = gt; it < (long)T_ * RH * RDV; it += gs) {
        const int v = (int)(it % RDV); long r = it / RDV; const int h = (int)(r % RH); const long t = r / RH;
        const int b = (int)(t / S_), s = (int)(t % S_), i = s % RCH, n = s / RCH;
        float a = 0.f;
        const float* p = P + (t * RH + h) * RCH;
        for (int j = 0; j <= i; ++j) a += p[j] * bf2f(z[(t - i + j) * RW + 2 * RH * RDK + h * RDV + v]);
        if (n > 0) {
            const float* st = ST + (size_t)(n - 1) * NB * RH * RDK * RDV + ((size_t)(b * RH + h) * RDK) * RDV + v;
            const bf16* q = z + t * RW + h * RDK; float c = 0.f;
            for (int d = 0; d < RDK; ++d) c += bf2f(q[d]) * st[(size_t)d * RDV];
            a += c * expf(ret_lg(h) * (float)(i + 1));
        }
        O[it] = f2bf(a);
    }
}
HD void ph_ret_gn(const Ctx& C, long gt, long gs) {
    const bf16* z = C.w<bf16>(WS_QKVG); const bf16* O = C.w<bf16>(WS_RO); bf16* A2 = C.w<bf16>(WS_RA2);
    const float* gg = C.f(I_RET_GN_G); const float* gb = C.f(I_RET_GN_B);
    for (long it = gt; it < (long)T_ * RH; it += gs) {
        const int h = (int)(it % RH); const long t = it / RH;
        const bf16* o = O + (t * RH + h) * RDV;
        float s = 0.f; for (int v = 0; v < RDV; ++v) s += bf2f(o[v]);
        const float mu = s / RDV; float q = 0.f;
        for (int v = 0; v < RDV; ++v) { const float d = bf2f(o[v]) - mu; q += d * d; }
        const float rstd = 1.0f / sqrtf(q / RDV + LN_EPS);
        const bf16* g = z + t * RW + 2 * RH * RDK + RH * RDV + h * RDV;
        for (int v = 0; v < RDV; ++v) A2[(t * RH + h) * RDV + v] = f2bf(siluf_(bf2f(g[v])) * ((bf2f(o[v]) - mu) * rstd * gg[h * RDV + v] + gb[h * RDV + v]));
    }
}

HD void ph_conv_glu(const Ctx& C, long gt, long gs) {
    const bf16* raw = C.w<bf16>(WS_CRAW); bf16* U = C.w<bf16>(WS_CU);
    for (long it = gt; it < (long)T_ * D_; it += gs) { const long t = it / D_; const int c = (int)(it % D_);
        U[it] = f2bf(bf2f(raw[t * 2 * D_ + c]) * sigmoidf_(bf2f(raw[t * 2 * D_ + D_ + c]))); }
}
HD void ph_conv_dw(const Ctx& C, long gt, long gs) {
    const bf16* U = C.w<bf16>(WS_CU); float* CV = C.w<float>(WS_CCV); const float* wd = C.f(I_CONV_W_DW); const float* bd = C.f(I_CONV_B_DW);
    for (long it = gt; it < (long)T_ * D_; it += gs) { const long t = it / D_; const int c = (int)(it % D_); const int s = (int)(t % S_);
        float a = bd[c];
        for (int w = 0; w < CW; ++w) { const int sp = s - (CW - 1) + w; if (sp >= 0) a += bf2f(U[(t - (CW - 1) + w) * D_ + c]) * wd[w * D_ + c]; }
        CV[it] = a; }
}
HD void ph_conv_ln(const Ctx& C, long gt, long gs) {
    const float* CV = C.w<float>(WS_CCV); bf16* A2 = C.w<bf16>(WS_CA2); const float* g = C.f(I_CONV_LN_G); const float* bb = C.f(I_CONV_LN_B);
    for (long t = gt; t < T_; t += gs) { const float* r = CV + t * D_;
        float s = 0.f; for (int c = 0; c < D_; ++c) s += r[c];
        const float mu = s / D_; float q = 0.f; for (int c = 0; c < D_; ++c) { const float d = r[c] - mu; q += d * d; }
        const float rstd = 1.0f / sqrtf(q / D_ + LN_EPS);
        for (int c = 0; c < D_; ++c) A2[t * D_ + c] = f2bf(siluf_((r[c] - mu) * rstd * g[c] + bb[c])); }
}

HD void ph_pool(const Ctx& C, long gt, long gs) {
    const bf16* H = C.w<bf16>(WS_H); bf16* PL = C.w<bf16>(WS_PL);
    for (long it = gt; it < (long)T_ * D_; it += gs) { const long t = it / D_; const int c = (int)(it % D_); const int s = (int)(t % S_);
        const int win = 2 << (c >> 8); const int lo = s + 1 - win > 0 ? s + 1 - win : 0; float a = 0.f;
        for (int sp = lo; sp <= s; ++sp) a += bf2f(H[(t - s + sp) * D_ + c]);
        PL[it] = f2bf(a / (float)(s + 1 - lo) - bf2f(H[it])); }
}

HD void ph_nsa_rope(const Ctx& C, long gt, long gs) {
    bf16* Q = C.w<bf16>(WS_NQ); bf16* KV = C.w<bf16>(WS_NKV);
    for (long it = gt; it < (long)T_ * 22 * 32; it += gs) {
        const int i = (int)(it & 31); long r = it >> 5; const int hh = (int)(r % 22); const long t = r / 22;
        bf16* p; float sc = 1.0f;
        if (hh < 16) { p = Q + t * D_ + hh * 64; sc = 0.125f; } else { const int k3 = (hh - 16) >> 1, g = (hh - 16) & 1; p = KV + t * NKVW + k3 * 256 + g * 64; }
        const float cs = C.w<float>(WS_COS64)[t * 32 + i], sn = C.w<float>(WS_SIN64)[t * 32 + i];
        const float x1 = bf2f(p[i]), x2 = bf2f(p[i + 32]);
        p[i] = f2bf((x1 * cs - x2 * sn) * sc); p[i + 32] = f2bf((x1 * sn + x2 * cs) * sc);
    }
}
HD int nsa_nvalid_cmp(int s) { int nv = s >= 31 ? (s - 31) / 16 + 1 : 0; return nv > NCMP ? NCMP : nv; }
HD void ph_nsa_cmp_attn(const Ctx& C, long gt, long gs) {
    const bf16* Q = C.w<bf16>(WS_NQ); const bf16* CKV = C.w<bf16>(WS_CMPKV); float* PC = C.w<float>(WS_PC); float* OC = C.w<float>(WS_OC);
    for (long it = gt; it < (long)T_ * NH; it += gs) {
        const int hd = (int)(it % NH); const long t = it / NH; const int b = (int)(t / S_), s = (int)(t % S_), g = hd / NR; const int nv = nsa_nvalid_cmp(s);
        float q[64], o[64];
#pragma unroll
        for (int d = 0; d < 64; ++d) { q[d] = bf2f(Q[t * D_ + hd * 64 + d]); o[d] = 0.f; }
        const bf16* kc = CKV + ((size_t)(b * NG + g) * 256) * 64; const bf16* vc = CKV + ((size_t)(NBG + b * NG + g) * 256) * 64;
        float mx = -3.0e38f;
        for (int n = 0; n < nv; ++n) { float a = 0.f;
#pragma unroll
            for (int d = 0; d < 64; ++d) a += q[d] * bf2f(kc[n * 64 + d]);
            mx = fmaxf(mx, a); }
        float sum = 0.f;
        for (int n = 0; n < nv; ++n) { float a = 0.f;
#pragma unroll
            for (int d = 0; d < 64; ++d) a += q[d] * bf2f(kc[n * 64 + d]);
            sum += expf(a - mx); }
        const float inv = nv > 0 ? 1.0f / sum : 0.f;
        for (int n = 0; n < nv; ++n) { float a = 0.f;
#pragma unroll
            for (int d = 0; d < 64; ++d) a += q[d] * bf2f(kc[n * 64 + d]);
            const float p = expf(a - mx) * inv; PC[it * 256 + n] = p;
#pragma unroll
            for (int d = 0; d < 64; ++d) o[d] += p * bf2f(vc[n * 64 + d]); }
#pragma unroll
        for (int d = 0; d < 64; ++d) OC[t * D_ + hd * 64 + d] = o[d];
    }
}
HD void ph_nsa_select(const Ctx& C, long gt, long gs) {
    const float* PC = C.w<float>(WS_PC); float* IMP = C.w<float>(WS_IMP); u64* SELM = C.w<u64>(WS_SELM);
    for (long it = gt; it < (long)T_ * NG; it += gs) {
        const int g = (int)(it % NG); const long t = it / NG; const int s = (int)(t % S_), cur = s / 64, nv = nsa_nvalid_cmp(s);
        float* imp = IMP + it * 64;
        for (int j = 0; j <= cur; ++j) {
            float a;
            if (j == 0 || j == cur || j == cur - 1) a = 1.0e6f;
            else { a = 0.f; int n0 = 4 * j - 1, n1 = 4 * j + 3; if (n0 < 0) n0 = 0; if (n1 > nv - 1) n1 = nv - 1;
                for (int r = 0; r < NR; ++r) for (int n = n0; n <= n1; ++n) a += PC[(t * NH + g * NR + r) * 256 + n]; }
            imp[j] = a;
        }
        const int nsel = (cur + 1) < KSEL ? (cur + 1) : KSEL; u64 taken = 0;
        for (int p = 0; p < nsel; ++p) { float best = -3.0e38f; int bj = 0;
            for (int j = 0; j <= cur; ++j) if (!((taken >> j) & 1ull)) { const float v = imp[j]; if (v > best) { best = v; bj = j; } }
            taken |= 1ull << bj; }
        SELM[it] = taken;
    }
}
HD void ph_nsa_attn(const Ctx& C, long gt, long gs) {
    const bf16* Q = C.w<bf16>(WS_NQ); const bf16* KV = C.w<bf16>(WS_NKV); const float* OC = C.w<float>(WS_OC); const u64* SELM = C.w<u64>(WS_SELM);
    const float* GT = C.w<float>(WS_NGT); bf16* NO = C.w<bf16>(WS_NO);
    for (long it = gt; it < (long)T_ * NH; it += gs) {
        const int hd = (int)(it % NH); const long t = it / NH; const int s = (int)(t % S_), g = hd / NR, cur = s / 64; const long tb = t - s;
        float q[64], o[64], o2[64];
#pragma unroll
        for (int d = 0; d < 64; ++d) { q[d] = bf2f(Q[t * D_ + hd * 64 + d]); o[d] = 0.f; o2[d] = 0.f; }
        const u64 sel = SELM[t * NG + g];
        float m = -3.0e38f, l = 0.f;
        for (int j = 0; j <= cur; ++j) if ((sel >> j) & 1ull) {
            const int kend = (64 * j + 63) < s ? (64 * j + 63) : s;
            for (int kp = 64 * j; kp <= kend; ++kp) {
                const bf16* kr = KV + (tb + kp) * NKVW + 256 + g * 64; const bf16* vr = KV + (tb + kp) * NKVW + 384 + g * 64;
                float a = 0.f;
#pragma unroll
                for (int d = 0; d < 64; ++d) a += q[d] * bf2f(kr[d]);
                const float mn = fmaxf(m, a), corr = expf(m - mn), p = expf(a - mn);
                l = l * corr + p; m = mn;
#pragma unroll
                for (int d = 0; d < 64; ++d) o[d] = o[d] * corr + p * bf2f(vr[d]);
            }
        }
        float m2 = -3.0e38f, l2 = 0.f;
        for (int kp = (s - (NWIN - 1) > 0 ? s - (NWIN - 1) : 0); kp <= s; ++kp) {
            const bf16* kr = KV + (tb + kp) * NKVW + 512 + g * 64; const bf16* vr = KV + (tb + kp) * NKVW + 640 + g * 64;
            float a = 0.f;
#pragma unroll
            for (int d = 0; d < 64; ++d) a += q[d] * bf2f(kr[d]);
            const float mn = fmaxf(m2, a), corr = expf(m2 - mn), p = expf(a - mn);
            l2 = l2 * corr + p; m2 = mn;
#pragma unroll
            for (int d = 0; d < 64; ++d) o2[d] = o2[d] * corr + p * bf2f(vr[d]);
        }
        const float gc = GT[t * 48 + hd * 3 + 0], gs_ = GT[t * 48 + hd * 3 + 1] / l, gw = GT[t * 48 + hd * 3 + 2] / l2;
#pragma unroll
        for (int d = 0; d < 64; ++d) NO[t * D_ + hd * 64 + d] = f2bf(gc * OC[t * D_ + hd * 64 + d] + gs_ * o[d] + gw * o2[d]);
    }
}

struct GBase { int Z, MT  , N, K; };
struct G_Dense : GBase {
    const bf16* A; int lda; const float* W; int ldw; const float* bias; bf16* O; int ldo;
    HD int rows(int) const { return T_; }
    HD float Af(int, int m, int k) const { return bf2f(A[(size_t)m * lda + k]); }
    HD float Bf(int, int k, int n) const { return W[(size_t)k * ldw + n]; }
    HD void epi(int, int m, int n, float v) const { O[(size_t)m * ldo + n] = f2bf(v + (bias ? bias[n] : 0.f)); }
};
struct G_NsaIn : GBase {
    const bf16* A; const float* W; bf16* Q; bf16* KV; float* GT; const float* gate_b;
    HD int rows(int) const { return T_; }
    HD float Af(int, int m, int k) const { return bf2f(A[(size_t)m * D_ + k]); }
    HD float Bf(int, int k, int n) const { return W[(size_t)k * NINW + n]; }
    HD void epi(int, int m, int n, float v) const {
        if (n < 1024) Q[(size_t)m * D_ + n] = f2bf(v); else if (n < 1792) KV[(size_t)m * NKVW + (n - 1024)] = f2bf(v); else GT[(size_t)m * 48 + (n - 1792)] = sigmoidf_(v + gate_b[n - 1792]); }
};
struct G_Cmp1 : GBase {
    const bf16* KV; const float* w1k; const float* w1v; const float* cb; bf16* H;
    HD int rows(int) const { return NCMP; }
    HD float Af(int z, int m, int k) const { const int tz = z / NBG, bg = z % NBG, b = bg / NG, g = bg % NG; return bf2f(KV[((size_t)b * S_ + 16 * m + (k >> 6)) * NKVW + tz * 128 + g * 64 + (k & 63)]); }
    HD float Bf(int z, int k, int n) const { return (z / NBG ? w1v : w1k)[(size_t)k * 256 + n]; }
    HD void epi(int z, int m, int n, float v) const { H[((size_t)z * 256 + m) * 256 + n] = f2bf(gelu_tanh(v + cb[(z / NBG) * 256 + n])); }
};
struct G_Cmp2 : GBase {
    const bf16* H; const float* w2k; const float* w2v; bf16* O;
    HD int rows(int) const { return NCMP; }
    HD float Af(int z, int m, int k) const { return bf2f(H[((size_t)z * 256 + m) * 256 + k]); }
    HD float Bf(int z, int k, int n) const { return (z / NBG ? w2v : w2k)[(size_t)k * 64 + n]; }
    HD void epi(int z, int m, int n, float v) const { O[((size_t)z * 256 + m) * 64 + n] = f2bf(v); }
};
struct G_Pool : GBase {
    const bf16* PL; const float* W; const float* pb; const float* ps; bf16* Y;
    HD int rows(int) const { return T_; }
    HD float Af(int z, int m, int k) const { return bf2f(PL[(size_t)m * D_ + z * 256 + k]); }
    HD float Bf(int z, int k, int n) const { return W[((size_t)z * 256 + k) * 256 + n]; }
    HD void epi(int z, int m, int n, float v) const { const int c = z * 256 + n; Y[(size_t)m * D_ + c] = f2bf((v + pb[c]) * ps[c]); }
};
struct G_MoeUp : GBase {
    const bf16* Hh; const int* list; const int* cnt; const float* W; const float* b1; bf16* GU;
    HD int rows(int z) const { return cnt[z]; }
    HD float Af(int z, int m, int k) const { return bf2f(Hh[(size_t)(list[(size_t)z * T_ + m] >> 2) * D_ + k]); }
    HD float Bf(int z, int k, int n) const { return W[((size_t)z * D_ + k) * 2 * DFF + n]; }
    HD void epi(int z, int m, int n, float v) const { GU[(size_t)list[(size_t)z * T_ + m] * 2 * DFF + n] = f2bf(v + b1[z * 2 * DFF + n]); }
};
struct G_MoeDown : GBase {
    const bf16* ACT; const int* list; const int* cnt; const float* W; const float* b2; bf16* YS;
    HD int rows(int z) const { return cnt[z]; }
    HD float Af(int z, int m, int k) const { return bf2f(ACT[(size_t)list[(size_t)z * T_ + m] * DFF + k]); }
    HD float Bf(int z, int k, int n) const { return W[((size_t)z * DFF + k) * D_ + n]; }
    HD void epi(int z, int m, int n, float v) const { YS[(size_t)list[(size_t)z * T_ + m] * D_ + n] = f2bf(v + b2[z * D_ + n]); }
};

HD G_Dense mk_dense(const bf16* A, int lda, const float* W, int K, int N, const float* bias, bf16* O, int ldo) {
    G_Dense g; g.Z = 1; g.MT = T_ / 128; g.N = N; g.K = K; g.A = A; g.lda = lda; g.W = W; g.ldw = N; g.bias = bias; g.O = O; g.ldo = ldo; return g; }

#ifdef HOSTTEST
template <class G> void gemm_host(const G& g) {
    for (int z = 0; z < g.Z; ++z) {
        const int rows = g.rows(z); if (rows <= 0) continue;
        float* Bz = (float*)malloc((size_t)g.K * g.N * 4);
        for (int k = 0; k < g.K; ++k) for (int n = 0; n < g.N; ++n) Bz[(size_t)k * g.N + n] = bfr(g.Bf(z, k, n));
#pragma omp parallel
        {
            float* ar = (float*)malloc(g.K * 4); float* acc = (float*)malloc(g.N * 4);
#pragma omp for schedule(dynamic, 8)
            for (int m = 0; m < rows; ++m) {
                for (int k = 0; k < g.K; ++k) ar[k] = bfr(g.Af(z, m, k));
                for (int n = 0; n < g.N; ++n) acc[n] = 0.f;
                for (int k = 0; k < g.K; ++k) { const float a = ar[k]; const float* br = Bz + (size_t)k * g.N; for (int n = 0; n < g.N; ++n) acc[n] += a * br[n]; }
                for (int n = 0; n < g.N; ++n) g.epi(z, m, n, acc[n]);
            }
            free(ar); free(acc);
        }
        free(Bz);
    }
}
#define GEMM(g) gemm_host(g)
#include <omp.h>
#define PHASE(call_with_gt_gs) do { _Pragma("omp parallel") { const long gt = omp_get_thread_num(), gs = omp_get_num_threads(); call_with_gt_gs; } } while (0)
#else
#define GAS __attribute__((address_space(1)))
#define LAS __attribute__((address_space(3)))
typedef short bf16x8 __attribute__((ext_vector_type(8)));
typedef float f32x4 __attribute__((ext_vector_type(4)));
typedef unsigned u32x4 __attribute__((ext_vector_type(4)));
typedef unsigned u32x2 __attribute__((ext_vector_type(2)));
constexpr int NTHREADS = 512;
constexpr int LDS_BYTES = 147456;
constexpr int LDS_MISC = LDS_BYTES - 256;

template <class G> __device__ __forceinline__ void gemm_naive(const G& g, LAS unsigned char* lds) {
    int tid_ = threadIdx.x; asm volatile("" : "+v"(tid_)); const int tid = tid_, lane = tid & 63, w = tid >> 6, wm = w >> 2, wn = w & 3, fr = lane & 15, fq = lane >> 4;
    LAS bf16* As = (LAS bf16*)lds; LAS bf16* Bs = As + 128 * 40;
    const int NT = (g.N + 127) / 128; const long ntiles = (long)g.Z * g.MT * NT;
    const int ar = tid >> 2, aks = (tid & 3) * 8, bn = tid & 127, bks = (tid >> 7) * 8;
    for (long tile = blockIdx.x; tile < ntiles; tile += gridDim.x) {
        const int mt = (int)(tile % g.MT); const long r = tile / g.MT; const int nt = (int)(r % NT), z = (int)(r / NT);
        const int rows = g.rows(z), m0 = mt * 128, n0 = nt * 128;
        if (m0 >= rows) continue;
        f32x4 acc[4][2];
#pragma unroll
        for (int i = 0; i < 4; ++i)
#pragma unroll
            for (int j = 0; j < 2; ++j) acc[i][j] = (f32x4){0.f, 0.f, 0.f, 0.f};
        for (int k0 = 0; k0 < g.K; k0 += 32) {
            { const int m = m0 + ar; bf16x8 v;
#pragma unroll
              for (int j = 0; j < 8; ++j) v[j] = (m < rows) ? (short)f2bf(g.Af(z, m, k0 + aks + j)) : (short)0;
              *(LAS bf16x8*)(As + ar * 40 + aks) = v; }
            { const int n = n0 + bn; bf16x8 v;
#pragma unroll
              for (int j = 0; j < 8; ++j) v[j] = (n < g.N) ? (short)f2bf(g.Bf(z, k0 + bks + j, n)) : (short)0;
              *(LAS bf16x8*)(Bs + bn * 40 + bks) = v; }
            __syncthreads();
            bf16x8 af[4], bq[2];
#pragma unroll
            for (int i = 0; i < 4; ++i) af[i] = *(LAS bf16x8*)(As + (wm * 64 + i * 16 + fr) * 40 + fq * 8);
#pragma unroll
            for (int j = 0; j < 2; ++j) bq[j] = *(LAS bf16x8*)(Bs + (wn * 32 + j * 16 + fr) * 40 + fq * 8);
#pragma unroll
            for (int i = 0; i < 4; ++i)
#pragma unroll
                for (int j = 0; j < 2; ++j) acc[i][j] = __builtin_amdgcn_mfma_f32_16x16x32_bf16(af[i], bq[j], acc[i][j], 0, 0, 0);
            __syncthreads();
        }
#pragma unroll
        for (int i = 0; i < 4; ++i)
#pragma unroll
            for (int j = 0; j < 2; ++j)
#pragma unroll
                for (int rr = 0; rr < 4; ++rr) { const int row = m0 + wm * 64 + i * 16 + fq * 4 + rr, col = n0 + wn * 32 + j * 16 + fr;
                    if (row < rows && col < g.N) g.epi(z, row, col, acc[i][j][rr]); }
    }
}
#define GEMM(g) gemm_naive(g, lds)
#define PHASE(call_with_gt_gs) do { call_with_gt_gs; } while (0)

#define XB_TMO      128
#define XB_XCNT(j)  (256  + 64 * (j))
#define XB_XSUB(j)  (1280 + 64 * (j))
#define XB_XGEN(j)  (2304 + 64 * (j))
#define XB_TOP      3328
#define XB_TOPGEN   3392
#define XCD_BAR_WORDS 3456
#define XB_SPIN_CAP (1u << 24)
__device__ __forceinline__ unsigned xb_ld(unsigned* p)              { return __hip_atomic_load(p, __ATOMIC_RELAXED, __HIP_MEMORY_SCOPE_AGENT); }
__device__ __forceinline__ unsigned xb_add(unsigned* p, unsigned v) { return __hip_atomic_fetch_add(p, v, __ATOMIC_RELAXED, __HIP_MEMORY_SCOPE_AGENT); }
__device__ __forceinline__ unsigned xb_xcc_id() { return (unsigned)__builtin_amdgcn_s_getreg((3 << 11) | 20) & 0xFu; }
#define XB_SPIN(cond, bar) do { unsigned _sp = 0; while (cond) { __builtin_amdgcn_s_sleep(1); \
    if ((++_sp & 255u) == 0u) { if (xb_ld(&(bar)[XB_TMO])) break; if (_sp > XB_SPIN_CAP) { atomicAdd(&(bar)[XB_TMO], 1u); break; } } } } while (0)
struct XcdBarrier { unsigned* bar; unsigned x; volatile LAS unsigned* st; };
__device__ __forceinline__ XcdBarrier xcd_barrier_post(unsigned* bar, volatile LAS unsigned* st) {
    XcdBarrier b; b.bar = bar; b.x = xb_xcc_id(); b.st = st;
    if (threadIdx.x == 0) (void)xb_add(&bar[XB_XCNT(b.x)], 1u);
    return b;
}
__device__ __forceinline__ void xcd_barrier_complete(unsigned* bar, unsigned x, unsigned& nloc, unsigned& nx) {
    const unsigned G = gridDim.x * gridDim.y * gridDim.z;
    unsigned sum, cnt, mine, sp = 0u;
    for (;;) {
        sum = 0u; cnt = 0u; mine = 0u;
#pragma unroll
        for (unsigned j = 0; j < 16; ++j) { const unsigned c = xb_ld(&bar[XB_XCNT(j)]); sum += c; cnt += (c > 0u) ? 1u : 0u; mine = (j == x) ? c : mine; }
        if (sum == G) break;
        __builtin_amdgcn_s_sleep(1);
        if ((++sp & 255u) == 0u) { if (xb_ld(&bar[XB_TMO])) break; if (sp > XB_SPIN_CAP) { atomicAdd(&bar[XB_TMO], 1u); break; } }
    }
    nloc = mine > 0u ? mine : 1u; nx = cnt > 0u ? cnt : 1u;
}
__device__ __forceinline__ void xcd_barrier(const XcdBarrier& b) {
    asm volatile("s_waitcnt vmcnt(0)" ::: "memory");
    __syncthreads();
    if (threadIdx.x == 0) {
        unsigned* bar = b.bar;
        __builtin_amdgcn_s_waitcnt(0);
        unsigned nloc = b.st[0], nx = b.st[1];
        if (nloc == 0u) { xcd_barrier_complete(bar, b.x, nloc, nx); b.st[0] = nloc; b.st[1] = nx; }
        const unsigned old = xb_add(&bar[XB_XSUB(b.x)], 1u);
        const unsigned gen = old / nloc;
        if (old + 1u == (gen + 1u) * nloc) {
            __builtin_amdgcn_fence(__ATOMIC_RELEASE, "agent");
            asm volatile("s_waitcnt vmcnt(0)" ::: "memory");
            const unsigned og = xb_add(&bar[XB_TOP], 1u);
            const unsigned tg = og / nx;
            if (og + 1u == (tg + 1u) * nx) xb_add(&bar[XB_TOPGEN], 1u);
            else XB_SPIN(xb_ld(&bar[XB_TOPGEN]) == tg, bar);
            __builtin_amdgcn_fence(__ATOMIC_ACQUIRE, "agent");
            xb_add(&bar[XB_XGEN(b.x)], 1u);
            asm volatile("s_waitcnt vmcnt(0)" ::: "memory");
        } else {
            XB_SPIN(xb_ld(&bar[XB_XGEN(b.x)]) == gen, bar);
            __builtin_amdgcn_fence(__ATOMIC_ACQUIRE, "agent");
            asm volatile("s_waitcnt vmcnt(0)" ::: "memory");
        }
    }
    __syncthreads();
}
#endif


#ifndef HOSTTEST
__device__ __forceinline__ unsigned cvt_pk_bf16(float lo, float hi) { unsigned r; asm volatile("v_cvt_pk_bf16_f32 %0, %1, %2" : "=v"(r) : "v"(lo), "v"(hi)); return r; }
__device__ __forceinline__ float fast_sigmoid(float x) { return __builtin_amdgcn_rcpf(1.0f + __builtin_amdgcn_exp2f(-1.4426950408889634f * x)); }

constexpr float KREP = (PROBE_KIND == 10) ? 2.0f : 1.0f;
constexpr float W1_SCALE = 64.0f * KREP, W2_SCALE = 128.0f * KREP, ACT_SCALE = 8.0f, YC_SCALE = 32.0f;
typedef float f32x2_ __attribute__((ext_vector_type(2)));
__device__ __forceinline__ f32x4 fp8x4(int p) { const f32x2_ lo = __builtin_amdgcn_cvt_pk_f32_fp8(p, false), hi = __builtin_amdgcn_cvt_pk_f32_fp8(p, true); return (f32x4){lo[0], lo[1], hi[0], hi[1]}; }
__device__ __forceinline__ unsigned pk4_fp8(float a, float b, float c, float d) { int p = 0; p = __builtin_amdgcn_cvt_pk_fp8_f32(a, b, p, false); p = __builtin_amdgcn_cvt_pk_fp8_f32(c, d, p, true); return (unsigned)p; }
struct MapId { __device__ static int map(int n) { return n; } };
struct MapGlu { __device__ static int map(int n) { return ((n >> 7) & 1) * 1024 + (n >> 8) * 128 + (n & 127); } };
struct MapNsa { __device__ static int map(int n) { const int pn = n >> 8, bj = (n >> 7) & 1, j = n & 127, u = j >> 5, i = j & 31;
    if (pn < 4) return (4 * pn + u) * 64 + bj * 32 + i;
    if (pn == 4) return 1024 + (u < 2 ? 0 : 256) + (u & 1) * 64 + bj * 32 + i;
    if (pn == 5) return j < 64 ? 1536 + u * 64 + bj * 32 + i : 1152 + bj * 64 + (j - 64);
    if (pn == 6) return (bj ? 1664 : 1408) + j;
    return (bj == 0 && j < 48) ? 1792 + j : -1; } };
template <class MAP, bool FP8 = false> __device__ __forceinline__ void cvt_weights(const float* W, int ldw, int K, int N, bf16* WT, int nbatch, size_t sstride, size_t dstride, LAS unsigned char* lds, float scale = 1.0f) {
    const int lane = threadIdx.x & 63, wave = threadIdx.x >> 6;
    LAS float* scr = (LAS float*)(lds + wave * 16896);
    const int nkb = K / 64, nnb = N / 64; const long nitems = (long)nbatch * nkb * nnb;
    for (long it = (long)blockIdx.x * 8 + wave; it < nitems; it += (long)gridDim.x * 8) {
        const int nb = (int)(it % nnb); const long r = it / nnb; const int kb = (int)(r % nkb), z = (int)(r / nkb);
        const float* Wz = W + (size_t)z * sstride; bf16* WTz = FP8 ? (bf16*)((unsigned char*)WT + (size_t)z * dstride) : WT + (size_t)z * dstride;
        const int k0 = kb * 64, n0 = nb * 64, sc = MAP::map(n0 + lane);
        float wv[64];
        const float* wp = Wz + (size_t)k0 * ldw + (sc >= 0 ? sc : 0);
#pragma unroll
        for (int kk = 0; kk < 64; ++kk) wv[kk] = wp[(size_t)kk * ldw];
#pragma unroll
        for (int kk = 0; kk < 64; ++kk) scr[kk * 65 + lane] = sc >= 0 ? wv[kk] : 0.f;
        asm volatile("s_waitcnt lgkmcnt(0)" ::: "memory");
        const int c = lane & 7;
#pragma unroll
        for (int j = 0; j < 8; ++j) { const int n = (lane >> 3) + 8 * j; const LAS float* sp = scr + (8 * c) * 65 + n;
            if (FP8) { u32x2 o; o.x = pk4_fp8(sp[0] * scale, sp[65] * scale, sp[2 * 65] * scale, sp[3 * 65] * scale); o.y = pk4_fp8(sp[4 * 65] * scale, sp[5 * 65] * scale, sp[6 * 65] * scale, sp[7 * 65] * scale);
                *(u32x2*)((unsigned char*)WTz + (size_t)(n0 + n) * K + k0 + 8 * c) = o; }
            else { u32x4 o; o.x = cvt_pk_bf16(sp[0], sp[65]); o.y = cvt_pk_bf16(sp[2 * 65], sp[3 * 65]); o.z = cvt_pk_bf16(sp[4 * 65], sp[5 * 65]); o.w = cvt_pk_bf16(sp[6 * 65], sp[7 * 65]);
                *(u32x4*)(WTz + (size_t)(n0 + n) * K + k0 + 8 * c) = o; } }
        asm volatile("s_waitcnt lgkmcnt(0)" ::: "memory");
    }
}

template <class MAP> __device__ __forceinline__ void cvt_weights8(const float* W, int ldw, int K, int N, unsigned char* WT, int nbatch, size_t sstride, size_t dstride, LAS unsigned char* lds, float scale) {
    const int lane = threadIdx.x & 63, wave = threadIdx.x >> 6;
    LAS float* scr = (LAS float*)(lds + wave * 16896);
    const int nkb = K / 128, nnb = N / 32; const long nitems = (long)nbatch * nkb * nnb;
    for (long it = (long)blockIdx.x * 8 + wave; it < nitems; it += (long)gridDim.x * 8) {
        const int nb = (int)(it % nnb); const long r = it / nnb; const int kb = (int)(r % nkb), z = (int)(r / nkb);
        const float* Wz = W + (size_t)z * sstride; unsigned char* WTz = WT + (size_t)z * dstride;
        const int k0 = kb * 128, n0 = nb * 32, sc = MAP::map(n0 + (lane & 31)), kh = lane >> 5;
        float wv[64];
        const float* wp = Wz + (size_t)(k0 + kh) * ldw + (sc >= 0 ? sc : 0);
#pragma unroll
        for (int kk = 0; kk < 64; ++kk) wv[kk] = wp[(size_t)(2 * kk) * ldw];
#pragma unroll
        for (int kk = 0; kk < 64; ++kk) scr[(2 * kk + kh) * 33 + (lane & 31)] = sc >= 0 ? wv[kk] * scale : 0.f;
        asm volatile("s_waitcnt lgkmcnt(0)" ::: "memory");
        const int n = lane >> 1, half = lane & 1; const LAS float* sp = scr + (64 * half) * 33 + n;
        unsigned char* op = WTz + (size_t)(n0 + n) * K + k0 + 64 * half;
#pragma unroll
        for (int q = 0; q < 4; ++q) { u32x4 o;
            o.x = pk4_fp8(sp[(16 * q + 0) * 33], sp[(16 * q + 1) * 33], sp[(16 * q + 2) * 33], sp[(16 * q + 3) * 33]); o.y = pk4_fp8(sp[(16 * q + 4) * 33], sp[(16 * q + 5) * 33], sp[(16 * q + 6) * 33], sp[(16 * q + 7) * 33]);
            o.z = pk4_fp8(sp[(16 * q + 8) * 33], sp[(16 * q + 9) * 33], sp[(16 * q + 10) * 33], sp[(16 * q + 11) * 33]); o.w = pk4_fp8(sp[(16 * q + 12) * 33], sp[(16 * q + 13) * 33], sp[(16 * q + 14) * 33], sp[(16 * q + 15) * 33]);
            *(u32x4*)(op + 16 * q) = o; }
        asm volatile("s_waitcnt lgkmcnt(0)" ::: "memory");
    }
}
__device__ __forceinline__ void ph_convert_weights(const Ctx& C, LAS unsigned char* lds) {
    cvt_weights8<MapGlu>(C.f(I_MOE_W1), 2 * DFF, D_, 2 * DFF, C.w<unsigned char>(WS_W1T), DEPTH * NE, (size_t)D_ * 2 * DFF, (size_t)2 * DFF * D_, lds, W1_SCALE / KREP);
    cvt_weights8<MapId>(C.f(I_MOE_W2), D_, DFF, D_, C.w<unsigned char>(WS_W2T), DEPTH * NE, (size_t)DFF * D_, (size_t)D_ * DFF, lds, W2_SCALE / KREP);
    cvt_weights<MapId>(C.f(I_RET_W_IN), RW, D_, RW, C.w<bf16>(WS_RWIN), 1, 0, 0, lds);
    cvt_weights<MapId>(C.f(I_RET_W_OUT), D_, 2048, D_, C.w<bf16>(WS_RWOUT), 1, 0, 0, lds);
    cvt_weights<MapGlu>(C.f(I_CONV_W_PW1), 2 * D_, D_, 2 * D_, C.w<bf16>(WS_CPW1), 1, 0, 0, lds);
    cvt_weights<MapId>(C.f(I_CONV_W_PW2), D_, D_, D_, C.w<bf16>(WS_CPW2), 1, 0, 0, lds);
    cvt_weights<MapNsa>(C.f(I_NSA_W_IN), NINW, D_, 2048, C.w<bf16>(WS_NWIN), 1, 0, 0, lds);
    cvt_weights<MapId>(C.f(I_NSA_W_OUT), D_, D_, D_, C.w<bf16>(WS_NWOUT), 1, 0, 0, lds);
    cvt_weights<MapId>(C.f(I_NSA_K_W1), 256, 2048, 256, C.w<bf16>(WS_CW1T), 1, 0, 0, lds);
    cvt_weights<MapId>(C.f(I_NSA_V_W1), 256, 2048, 256, C.w<bf16>(WS_CW1T) + 256 * 2048, 1, 0, 0, lds);
    cvt_weights<MapId>(C.f(I_POOL_W), 256, 256, 256, C.w<bf16>(WS_PWT), 4, (size_t)256 * 256, (size_t)256 * 256, lds);
}


__device__ __forceinline__ u32x4 pg8_pack8(const f32x4& a, const f32x4& b) { u32x4 w; w.x = cvt_pk_bf16(a[0], a[1]); w.y = cvt_pk_bf16(a[2], a[3]); w.z = cvt_pk_bf16(b[0], b[1]); w.w = cvt_pk_bf16(b[2], b[3]); return w; }
template <int CTRL> __device__ __forceinline__ float dppf(float v) { return __builtin_bit_cast(float, __builtin_amdgcn_update_dpp(0, __builtin_bit_cast(int, v), CTRL, 0xf, 0xf, true)); }
template <int CTRL> __device__ __forceinline__ int dppi(int v) { return __builtin_amdgcn_update_dpp(0, v, CTRL, 0xf, 0xf, true); }
constexpr int DPP_X1 = 0xB1, DPP_X2 = 0x4E, DPP_HM = 0x141, DPP_RM = 0x140;
__device__ __forceinline__ float row16_max(float v) { v = fmaxf(v, dppf<DPP_X1>(v)); v = fmaxf(v, dppf<DPP_X2>(v)); v = fmaxf(v, dppf<DPP_HM>(v)); return fmaxf(v, dppf<DPP_RM>(v)); }
__device__ __forceinline__ int row16_min(int v) { int o = dppi<DPP_X1>(v); v = o < v ? o : v; o = dppi<DPP_X2>(v); v = o < v ? o : v; o = dppi<DPP_HM>(v); v = o < v ? o : v; o = dppi<DPP_RM>(v); return o < v ? o : v; }
__device__ __forceinline__ float wave_sum(float v) {
    v += dppf<DPP_X1>(v); v += dppf<DPP_X2>(v); v += dppf<DPP_HM>(v); v += dppf<DPP_RM>(v);
    { const unsigned u = __builtin_bit_cast(unsigned, v); const auto r = __builtin_amdgcn_permlane16_swap(u, u, false, false); v = bits_f32(r[0]) + bits_f32(r[1]); }
    { const unsigned u = __builtin_bit_cast(unsigned, v); const auto r = __builtin_amdgcn_permlane32_swap(u, u, false, false); v = bits_f32(r[0]) + bits_f32(r[1]); }
    return v;
}
template <int WHICH, bool DRY = false, bool XIN32 = false, bool XOUT32 = false> __device__ __forceinline__ void ln_fast(const Ctx& C, const int l, LAS unsigned char* lds) {
    float* const xout = DRY ? C.w<float>(WS_MX) : C.out; bf16* const xb = C.w<bf16>(WS_XB); bf16* const hout = DRY ? C.w<bf16>(WS_MX) + (size_t)T_ * D_ * 2 : C.w<bf16>(WS_H);
    int tid_ = threadIdx.x; asm volatile("" : "+v"(tid_)); const int tid = tid_, lane = tid & 63, wave = tid >> 6;
    const float* xsrc = C.f(I_X);
    const bool has_next = WHICH == 0 || l + 1 < DEPTH; const int nl = WHICH ? l + 1 : l;
    LAS bf16* rwT = (LAS bf16*)lds;
    LAS int* tbase = (LAS int*)(lds + 69632);
    LAS int* lhist = (LAS int*)(lds + 70144); LAS int* lbase = lhist + 32;
    LAS int* wcnt = lbase + 32;
    LAS bf16* hs = (LAS bf16*)(lds + 70656 + wave * 8256);
    LAS u32x2* wl = (LAS u32x2*)(lds + 136704 + wave * 512);
    if (WHICH == 0 && tid < 32) lhist[tid] = 0;
    if (WHICH == 0 && tid < 8) wcnt[tid] = 0;
    if (WHICH == 0) { const float* rw = C.f(I_ROUTER_W) + (size_t)l * D_ * NE;
        for (int i = tid; i < D_ * NE; i += NTHREADS) { const int k = i >> 5, e = i & 31; rwT[e * 1032 + k] = f2bf(rw[i]); } }
    if (WHICH == 1) { if (tid == 0) { int a = 0; for (int e = 0; e < NE; ++e) { tbase[e] = a; a += (C.cnt(l)[e] + 255) >> 8; } } }
    __syncthreads();
    f32x4 gtv[4], shv[4], scv[4];
    const float* lgp = C.f(WHICH ? I_LN2_G : I_LN1_G) + l * D_ + 4 * lane; const float* lbp = C.f(WHICH ? I_LN2_B : I_LN1_B) + l * D_ + 4 * lane;
    f32x4 lgv[4], lbv[4];
#pragma unroll
    for (int j = 0; j < 4; ++j) { lgv[j] = *(const f32x4*)(lgp + 256 * j); lbv[j] = *(const f32x4*)(lbp + 256 * j); }
    const int nchunk = T_ / 16;
    for (int chunk = blockIdx.x * 8 + wave; chunk < nchunk; chunk += gridDim.x * 8) {
        const size_t row0 = (size_t)chunk * 16; const int b = (int)(row0 / S_);
        { const float* gt = C.mod(l, b, WHICH ? 5 : 2);
#pragma unroll
          for (int j = 0; j < 4; ++j) { gtv[j] = *(const f32x4*)(gt + 4 * lane + 256 * j);
              if (has_next) { shv[j] = *(const f32x4*)(C.mod(nl, b, WHICH ? 0 : 3) + 4 * lane + 256 * j); scv[j] = *(const f32x4*)(C.mod(nl, b, WHICH ? 1 : 4) + 4 * lane + 256 * j); } } }
        constexpr int RPI = WHICH == 0 ? 4 : 2;
        int4 epv = {0, 0, 0, 0}; float twv_x = 0.f, twv_y = 0.f, twv_z = 0.f, twv_w = 0.f;
        if (WHICH == 1) { const size_t tl = row0 + (lane & 15); epv = *(const int4*)(C.w<int>(WS_EP) + tl * 4); const f32x4 twv = *(const f32x4*)(C.w<float>(WS_TOPW) + tl * 4); twv_x = twv[0]; twv_y = twv[1]; twv_z = twv[2]; twv_w = twv[3]; }
        constexpr bool PREF = WHICH == 1;
        u32x2 rx[RPI][4]; f32x4 rxf[RPI][4]; u32x2 ry[RPI][4]; int rq[RPI][4][4]; f32x4 rtw[RPI];
        auto issue = [&](const int rp) {
#pragma unroll
            for (int rr = 0; rr < RPI; ++rr) {
                const size_t t = row0 + rp + rr;
#pragma unroll
                for (int j = 0; j < 4; ++j) { if constexpr (XIN32) rxf[rr][j] = *(const f32x4*)(xsrc + t * D_ + 4 * lane + 256 * j); else rx[rr][j] = *(const u32x2*)(xb + t * D_ + 4 * lane + 256 * j); }
                if (WHICH == 0) {
#pragma unroll
                    for (int j = 0; j < 4; ++j) ry[rr][j] = *(const u32x2*)(C.w<bf16>(WS_Y) + t * D_ + 4 * lane + 256 * j);
                } else {
                    const int rsel = rp + rr; f32x4 tw; int4 ep;
                    tw[0] = bits_f32((unsigned)__builtin_amdgcn_readlane((int)__builtin_bit_cast(unsigned, twv_x), rsel)); tw[1] = bits_f32((unsigned)__builtin_amdgcn_readlane((int)__builtin_bit_cast(unsigned, twv_y), rsel));
                    tw[2] = bits_f32((unsigned)__builtin_amdgcn_readlane((int)__builtin_bit_cast(unsigned, twv_z), rsel)); tw[3] = bits_f32((unsigned)__builtin_amdgcn_readlane((int)__builtin_bit_cast(unsigned, twv_w), rsel));
                    ep.x = __builtin_amdgcn_readlane(epv.x, rsel); ep.y = __builtin_amdgcn_readlane(epv.y, rsel); ep.z = __builtin_amdgcn_readlane(epv.z, rsel); ep.w = __builtin_amdgcn_readlane(epv.w, rsel);
                    const size_t y0 = (size_t)tbase[ep.x >> 20] * 256 + (ep.x & 0xfffff), y1 = (size_t)tbase[ep.y >> 20] * 256 + (ep.y & 0xfffff), y2 = (size_t)tbase[ep.z >> 20] * 256 + (ep.z & 0xfffff), y3 = (size_t)tbase[ep.w >> 20] * 256 + (ep.w & 0xfffff);
                    const unsigned char* YC = C.w<unsigned char>(WS_YC); rtw[rr] = tw * (1.0f / YC_SCALE);
#pragma unroll
                    for (int j = 0; j < 4; ++j) { rq[rr][j][0] = *(const int*)(YC + y0 * D_ + 4 * lane + 256 * j); rq[rr][j][1] = *(const int*)(YC + y1 * D_ + 4 * lane + 256 * j);
                        rq[rr][j][2] = *(const int*)(YC + y2 * D_ + 4 * lane + 256 * j); rq[rr][j][3] = *(const int*)(YC + y3 * D_ + 4 * lane + 256 * j); }
                }
            } };
        if constexpr (PREF) issue(0);
#pragma unroll 1
        for (int rp = 0; rp < 16; rp += RPI) {
            f32x4 v[RPI][4];
            if constexpr (!PREF) issue(rp);
#pragma unroll
            for (int rr = 0; rr < RPI; ++rr) {
#pragma unroll
                for (int j = 0; j < 4; ++j) { f32x4 xv; if constexpr (XIN32) xv = rxf[rr][j]; else { const u32x2 px = rx[rr][j]; xv = (f32x4){bits_f32(px.x << 16), bits_f32(px.x & 0xffff0000u), bits_f32(px.y << 16), bits_f32(px.y & 0xffff0000u)}; }
                    f32x4 yv;
                    if (WHICH == 0) { const u32x2 p = ry[rr][j]; yv = (f32x4){bits_f32(p.x << 16), bits_f32(p.x & 0xffff0000u), bits_f32(p.y << 16), bits_f32(p.y & 0xffff0000u)}; }
                    else { yv = fp8x4(rq[rr][j][0]) * rtw[rr][0]; yv += fp8x4(rq[rr][j][1]) * rtw[rr][1]; yv += fp8x4(rq[rr][j][2]) * rtw[rr][2]; yv += fp8x4(rq[rr][j][3]) * rtw[rr][3]; }
                    v[rr][j] = xv * DN_ALPHA + (gtv[j] + 1.0f) * yv; }
            }
            if constexpr (PREF) { if (rp + RPI < 16) issue(rp + RPI); }
#pragma unroll
            for (int rr = 0; rr < RPI; ++rr) {
                const size_t t = row0 + rp + rr;
                float sm = 0.f;
#pragma unroll
                for (int j = 0; j < 4; ++j) sm += (v[rr][j][0] + v[rr][j][1]) + (v[rr][j][2] + v[rr][j][3]);
                const float mu = wave_sum(sm) * (1.0f / D_); float q = 0.f;
#pragma unroll
                for (int j = 0; j < 4; ++j) { v[rr][j] = v[rr][j] - mu; q += (v[rr][j][0] * v[rr][j][0] + v[rr][j][1] * v[rr][j][1]) + (v[rr][j][2] * v[rr][j][2] + v[rr][j][3] * v[rr][j][3]); }
                const float rstd = __builtin_amdgcn_rsqf(wave_sum(q) * (1.0f / D_) + LN_EPS);
#pragma unroll
                for (int j = 0; j < 4; ++j) { const f32x4 xn = v[rr][j] * rstd * lgv[j] + lbv[j];
                    if constexpr (XOUT32 || DRY) *(f32x4*)(xout + t * D_ + 4 * lane + 256 * j) = xn; else { u32x2 px; px.x = cvt_pk_bf16(xn[0], xn[1]); px.y = cvt_pk_bf16(xn[2], xn[3]); *(u32x2*)(xb + t * D_ + 4 * lane + 256 * j) = px; }
                    if (has_next) { const f32x4 h = xn * (scv[j] + 1.0f) + shv[j]; u32x2 p; p.x = cvt_pk_bf16(h[0], h[1]); p.y = cvt_pk_bf16(h[2], h[3]);
                        if (WHICH == 0) { *(LAS u32x2*)(hs + ((rp + rr) & 3) * 1032 + 4 * lane + 256 * j) = p;
                            if (!DRY) *(unsigned*)(C.w<unsigned char>(WS_H8) + t * D_ + 4 * lane + 256 * j) = pk4_fp8(h[0], h[1], h[2], h[3]); }
                        else *(u32x2*)(hout + t * D_ + 4 * lane + 256 * j) = p; } }
            }
                    if (WHICH == 0) {
                asm volatile("s_waitcnt lgkmcnt(0)" ::: "memory");
                const int r16 = lane & 15, kg = lane >> 4;
                f32x4 pa[2] = {(f32x4){0.f, 0.f, 0.f, 0.f}, (f32x4){0.f, 0.f, 0.f, 0.f}};
#pragma unroll 8
                for (int sx = 0; sx < 32; ++sx) { const bf16x8 a = *(const LAS bf16x8*)(hs + (r16 & 3) * 1032 + 32 * sx + 8 * kg);
                    const bf16x8 b0 = *(const LAS bf16x8*)(rwT + r16 * 1032 + 32 * sx + 8 * kg), b1 = *(const LAS bf16x8*)(rwT + (16 + r16) * 1032 + 32 * sx + 8 * kg);
                    pa[0] = __builtin_amdgcn_mfma_f32_16x16x32_bf16(a, b0, pa[0], 0, 0, 0); pa[1] = __builtin_amdgcn_mfma_f32_16x16x32_bf16(a, b1, pa[1], 0, 0, 0); }
                const float rb0 = C.f(I_ROUTER_B)[l * NE + r16], rb1 = C.f(I_ROUTER_B)[l * NE + 16 + r16];
#pragma unroll
                for (int i = 0; i < 4; ++i) {
                    float l0 = pa[0][i] + rb0, l1 = pa[1][i] + rb1; float tv[4]; int rk0 = -1, rk1 = -1;
#pragma unroll
                    for (int kk = 0; kk < 4; ++kk) {
                        float mx = fmaxf(l0, l1);
                        mx = row16_max(mx);
                        int idx = (l0 == mx) ? r16 : ((l1 == mx) ? 16 + r16 : 64);
                        idx = row16_min(idx);
                        tv[kk] = mx; if (idx == r16) { rk0 = kk; l0 = -3.3e38f; } else if (idx == 16 + r16) { rk1 = kk; l1 = -3.3e38f; }
                    }
                    const float e1 = __builtin_amdgcn_exp2f((tv[1] - tv[0]) * 1.4426950408889634f), e2 = __builtin_amdgcn_exp2f((tv[2] - tv[0]) * 1.4426950408889634f), e3 = __builtin_amdgcn_exp2f((tv[3] - tv[0]) * 1.4426950408889634f); const float inv = __builtin_amdgcn_rcpf(1.0f + e1 + e2 + e3);
                    const size_t t = row0 + rp + i;
                    if (!DRY && kg == 0 && rk0 >= 0) { C.w<float>(WS_TOPW)[t * 4 + rk0] = (rk0 == 0 ? 1.0f : rk0 == 1 ? e1 : rk0 == 2 ? e2 : e3) * inv;
                        const int lp = __hip_atomic_fetch_add(lhist + r16, 1, __ATOMIC_RELAXED, __HIP_MEMORY_SCOPE_WORKGROUP), ps = __hip_atomic_fetch_add(wcnt + wave, 1, __ATOMIC_RELAXED, __HIP_MEMORY_SCOPE_WORKGROUP);
                        wl[ps] = (u32x2){(unsigned)t, (unsigned)(r16 | (rk0 << 8) | (lp << 16))}; }
                    if (!DRY && kg == 0 && rk1 >= 0) { C.w<float>(WS_TOPW)[t * 4 + rk1] = (rk1 == 0 ? 1.0f : rk1 == 1 ? e1 : rk1 == 2 ? e2 : e3) * inv;
                        const int lp = __hip_atomic_fetch_add(lhist + 16 + r16, 1, __ATOMIC_RELAXED, __HIP_MEMORY_SCOPE_WORKGROUP), ps = __hip_atomic_fetch_add(wcnt + wave, 1, __ATOMIC_RELAXED, __HIP_MEMORY_SCOPE_WORKGROUP);
                        wl[ps] = (u32x2){(unsigned)t, (unsigned)((16 + r16) | (rk1 << 8) | (lp << 16))}; }
                }
            }
        }
        if (WHICH == 0) {
            __syncthreads();
            if (tid < 32) lbase[tid] = atomicAdd(C.cnt(l) + tid, lhist[tid]);
            __syncthreads();
            if (!DRY && lane < wcnt[wave]) { const u32x2 en = wl[lane]; const int e = en.y & 0xff, rk = (en.y >> 8) & 0xff, p = lbase[e] + (int)(en.y >> 16);
                C.w<int>(WS_LIST)[(size_t)e * T_ + p] = (int)en.x; C.w<int>(WS_EP)[(size_t)en.x * 4 + rk] = (e << 20) | p; }
        }
    }
}

typedef float f32x16 __attribute__((ext_vector_type(16)));
typedef __bf16 bf16x2_t __attribute__((ext_vector_type(2)));
typedef float f32x2_t __attribute__((ext_vector_type(2)));
__device__ __forceinline__ unsigned cvtpk(float lo, float hi) { const f32x2_t v = {lo, hi}; const bf16x2_t b = __builtin_convertvector(v, bf16x2_t); return __builtin_bit_cast(unsigned, b); }
__device__ __forceinline__ int crow32(int i, int h) { return (i & 3) + 8 * (i >> 2) + 4 * h; }
constexpr float NSA_NEG = -1.0e30f, L2E = 1.4426950408889634f;
constexpr int KT_ELEMS = 64 * 72, VT_LD = 96, VT_ELEMS = 64 * VT_LD;
struct KVRegs { u32x4 k, v; };
__device__ __forceinline__ void kv_load(KVRegs& r, const bf16* K, const bf16* V, int stride, int tid) {
    r.k = *(const u32x4*)(K + (size_t)(tid >> 3) * stride + 8 * (tid & 7)); r.v = *(const u32x4*)(V + (size_t)(tid >> 3) * stride + 8 * (tid & 7)); }
__device__ __forceinline__ void kv_store(const KVRegs& r, LAS bf16* Ks, LAS bf16* Vt, int tid) {
    const int key = tid >> 3, ch = tid & 7;
    *(LAS u32x4*)(Ks + key * 72 + 8 * ch) = r.k;
    *(LAS u32x4*)(Vt + key * VT_LD + 8 * ch) = r.v;
}
template <int B> __device__ __forceinline__ void tr8(u32x2 (&a)[8], unsigned vb) {
    asm volatile("ds_read_b64_tr_b16 %0, %8 offset:%9\n\tds_read_b64_tr_b16 %1, %8 offset:%10\n\tds_read_b64_tr_b16 %2, %8 offset:%11\n\tds_read_b64_tr_b16 %3, %8 offset:%12\n\t"
                 "ds_read_b64_tr_b16 %4, %8 offset:%13\n\tds_read_b64_tr_b16 %5, %8 offset:%14\n\tds_read_b64_tr_b16 %6, %8 offset:%15\n\tds_read_b64_tr_b16 %7, %8 offset:%16"
                 : "=&v"(a[0]), "=&v"(a[1]), "=&v"(a[2]), "=&v"(a[3]), "=&v"(a[4]), "=&v"(a[5]), "=&v"(a[6]), "=&v"(a[7])
                 : "v"(vb), "i"(B + 0), "i"(B + 8 * VT_LD * 2), "i"(B + 64), "i"(B + 8 * VT_LD * 2 + 64), "i"(B + 16 * VT_LD * 2), "i"(B + 24 * VT_LD * 2), "i"(B + 16 * VT_LD * 2 + 64), "i"(B + 24 * VT_LD * 2 + 64) : "memory");
}
__device__ __forceinline__ void tr_wait(u32x2 (&a)[8]) {
    asm volatile("s_waitcnt lgkmcnt(0)" : "+v"(a[0]), "+v"(a[1]), "+v"(a[2]), "+v"(a[3]), "+v"(a[4]), "+v"(a[5]), "+v"(a[6]), "+v"(a[7]) :: "memory"); }
__device__ __forceinline__ void qk_tile(const LAS bf16* Ks, const bf16x8 (&qf)[4], f32x16& S0, f32x16& S1, int c, int h, float init) {
#pragma unroll
    for (int i = 0; i < 16; ++i) { S0[i] = init; S1[i] = init; }
#pragma unroll
    for (int sx = 0; sx < 4; ++sx) { const bf16x8 a0 = *(const LAS bf16x8*)(Ks + c * 72 + 16 * sx + 8 * h), a1 = *(const LAS bf16x8*)(Ks + (32 + c) * 72 + 16 * sx + 8 * h);
        S0 = __builtin_amdgcn_mfma_f32_32x32x16_bf16(a0, qf[sx], S0, 0, 0, 0); S1 = __builtin_amdgcn_mfma_f32_32x32x16_bf16(a1, qf[sx], S1, 0, 0, 0); }
}
constexpr float NSA_MASK = -2.0e30f, NSA_THR = 12.0f;
template <int MODE> __device__ __forceinline__ bool key_ok(int key, int s) {
    if (MODE == 0) return 16 * key + 31 <= s; if (MODE == 1) return key <= s; return key <= s && key > s - NWIN; }
template <int MODE> __device__ __forceinline__ void attn_tile(const LAS bf16* Ks, const LAS bf16* Vt, const bf16x8 (&qf)[4], f32x16 (&O)[2], float& m, float& l, int kbase, int s, bool on, bool masked, int c, int h) {
    const bool mset = m > -1.0e29f; const float mref = mset ? m : 0.f;
    f32x16 S0, S1; qk_tile(Ks, qf, S0, S1, c, h, on ? -mref : NSA_MASK);
    u32x2 va[8], vb8[8];
    { const int lane = c + 32 * h; const unsigned vbase = (unsigned)(unsigned long)Vt + (unsigned)((4 * (lane >> 5) + ((lane >> 2) & 3)) * (VT_LD * 2) + (16 * ((lane >> 4) & 1) + 4 * (lane & 3)) * 2);
      tr8<0>(va, vbase); tr8<32 * VT_LD * 2>(vb8, vbase); }
    if (masked) {
#pragma unroll
        for (int i = 0; i < 16; ++i) { const int k0 = kbase + crow32(i, h); S0[i] = key_ok<MODE>(k0, s) ? S0[i] : NSA_MASK; S1[i] = key_ok<MODE>(k0 + 32, s) ? S1[i] : NSA_MASK; } }
    float mx = NSA_MASK;
#pragma unroll
    for (int i = 0; i < 16; ++i) mx = __builtin_fmaxf(__builtin_fmaxf(mx, S0[i]), S1[i]);
    { const unsigned u = __builtin_bit_cast(unsigned, mx); const auto r = __builtin_amdgcn_permlane32_swap(u, u, false, false); mx = fmaxf(bits_f32(r[0]), bits_f32(r[1])); }
    const bool fix = mset ? (mx > NSA_THR) : (mx > -1.0e29f);
    if (__any(fix)) {
        const float delta = fix ? mx : 0.f, alpha = (fix && mset) ? __builtin_amdgcn_exp2f(-delta) : 1.0f;
#pragma unroll
        for (int i = 0; i < 16; ++i) { S0[i] -= delta; S1[i] -= delta; O[0][i] *= alpha; O[1][i] *= alpha; }
        l *= alpha; if (fix) m = mref + delta;
    }
    float ps = 0.f;
#pragma unroll
    for (int i = 0; i < 16; ++i) { S0[i] = __builtin_amdgcn_exp2f(S0[i]); S1[i] = __builtin_amdgcn_exp2f(S1[i]); ps += S0[i] + S1[i]; }
    l += ps;
    tr_wait(va); tr_wait(vb8);
#pragma unroll
    for (int blk = 0; blk < 2; ++blk)
#pragma unroll
        for (int s2 = 0; s2 < 2; ++s2) { const f32x16& P = blk ? S1 : S0; u32x4 pw;
            pw.x = cvt_pk_bf16(P[8 * s2 + 0], P[8 * s2 + 1]); pw.y = cvt_pk_bf16(P[8 * s2 + 2], P[8 * s2 + 3]); pw.z = cvt_pk_bf16(P[8 * s2 + 4], P[8 * s2 + 5]); pw.w = cvt_pk_bf16(P[8 * s2 + 6], P[8 * s2 + 7]);
            const bf16x8 pf = __builtin_bit_cast(bf16x8, pw);
#pragma unroll
            for (int db = 0; db < 2; ++db) { const u32x2 t0 = blk ? vb8[2 * (2 * s2 + db)] : va[2 * (2 * s2 + db)], t1 = blk ? vb8[2 * (2 * s2 + db) + 1] : va[2 * (2 * s2 + db) + 1];
                const u32x4 aw = {t0.x, t0.y, t1.x, t1.y};
                O[db] = __builtin_amdgcn_mfma_f32_32x32x16_bf16(__builtin_bit_cast(bf16x8, aw), pf, O[db], 0, 0, 0); } }
}
template <int MODE> __device__ __forceinline__ void attn_branch(const bf16* K0, const bf16* V0, int stride, int j0, int j1, int jm0, int jm1, LAS bf16* KsB, LAS bf16* VtB, const bf16x8 (&qf)[4],
                                                                 f32x16 (&O)[2], float& m, float& l, int s, u64 sel, int tid, int c, int h) {
    KVRegs r;
    if (j0 < j1) { kv_load(r, K0 + (size_t)j0 * 64 * stride, V0 + (size_t)j0 * 64 * stride, stride, tid); kv_store(r, KsB, VtB, tid); }
    if (j0 + 1 < j1) kv_load(r, K0 + (size_t)(j0 + 1) * 64 * stride, V0 + (size_t)(j0 + 1) * 64 * stride, stride, tid);
    __syncthreads();
    for (int j = j0; j < j1; ++j) {
        const int buf = (j - j0) & 1; const bool on = MODE == 1 ? (bool)((sel >> j) & 1ull) : true;
        if (MODE != 1 || __any(on))
            attn_tile<MODE>(KsB + buf * KT_ELEMS, VtB + buf * VT_ELEMS, qf, O, m, l, 64 * j, s, on, !(j >= jm0 && j < jm1), c, h);
        if (j + 1 < j1) { kv_store(r, KsB + (buf ^ 1) * KT_ELEMS, VtB + (buf ^ 1) * VT_ELEMS, tid);
            if (j + 2 < j1) kv_load(r, K0 + (size_t)(j + 2) * 64 * stride, V0 + (size_t)(j + 2) * 64 * stride, stride, tid); }
        __syncthreads();
    }
}
__device__ __forceinline__ void nsa_attn_fast(const Ctx& C, LAS unsigned char* lds) {
    int tid_ = threadIdx.x; asm volatile("" : "+v"(tid_)); const int tid = tid_, lane = tid & 63, wave = tid >> 6, c = lane & 31, h = lane >> 5;
    LAS bf16* KsB = (LAS bf16*)lds; LAS bf16* VtB = KsB + 2 * KT_ELEMS;
    LAS float* imp = (LAS float*)(lds + 2 * KT_ELEMS * 2 + 2 * VT_ELEMS * 2);
    LAS float* scr = imp + 32 * 64;
    const bf16* NQp = C.w<bf16>(WS_NQ); const bf16* KV = C.w<bf16>(WS_NKV); const bf16* CKV = C.w<bf16>(WS_CMPKV); const float* GT = C.w<float>(WS_NGT); bf16* NO = C.w<bf16>(WS_NO);
    const int nunits = NBG * (S_ / 32);
    const bool mirror = (gridDim.x % NBG) == 0 && ((S_ / 32) % (2 * (gridDim.x / NBG))) == 0; const int nr = gridDim.x / NBG;
    int round_ = 0;
    for (int unit0 = blockIdx.x; unit0 < nunits; unit0 += gridDim.x, ++round_) {
        int unit = unit0;
        if (mirror && (round_ & 1)) { const int r = blockIdx.x / NBG; unit = (blockIdx.x % NBG) + NBG * ((nr - 1 - r) + nr * round_); }
        const int bg = unit % NBG, tile = unit / NBG, b = bg / NG, g = bg % NG, s0 = tile * 32;
        const int s = s0 + wave * 4 + (c >> 3), hd = g * NR + (c & 7), cur = s0 >> 6; const size_t tb = (size_t)b * S_, t = tb + s;
        bf16x8 qf[4];
#pragma unroll
        for (int sx = 0; sx < 4; ++sx) qf[sx] = *(const bf16x8*)(NQp + t * D_ + hd * 64 + 16 * sx + 8 * h);
        f32x16 out[2], O[2];
#pragma unroll
        for (int i = 0; i < 16; ++i) { out[0][i] = 0.f; out[1][i] = 0.f; O[0][i] = 0.f; O[1][i] = 0.f; }
        for (int i = tid; i < 32 * 64; i += NTHREADS) imp[i] = 0.f;
        const bf16* Kc = CKV + (size_t)(b * NG + g) * 256 * 64; const bf16* Vc = CKV + (size_t)(NBG + b * NG + g) * 256 * 64;
        const int smax = s0 + 31, nvmax = smax >= 31 ? (smax - 31) / 16 + 1 : 0, nct = (nvmax + 63) / 64;
        float m = NSA_NEG, l = 0.f;
        attn_branch<0>(Kc, Vc, 64, 0, nct, 0, 0, KsB, VtB, qf, O, m, l, s, 0ull, tid, c, h);
        { const float lt = l + __shfl_xor(l, 32); const float sc = lt > 0.f ? GT[t * 48 + (hd) * 3 + 0] / lt : 0.f;
#pragma unroll
          for (int i = 0; i < 16; ++i) { out[0][i] += O[0][i] * sc; out[1][i] += O[1][i] * sc; O[0][i] = 0.f; O[1][i] = 0.f; }
          const float linv = lt > 0.f ? 1.0f / lt : 0.f;
          for (int j = 0; j < nct; ++j) {
              KVRegs r; kv_load(r, Kc + (size_t)j * 64 * 64, Vc + (size_t)j * 64 * 64, 64, tid); kv_store(r, KsB, VtB, tid);
              __syncthreads();
              f32x16 S0, S1; qk_tile(KsB, qf, S0, S1, c, h, 0.f);
#pragma unroll
              for (int blk = 0; blk < 2; ++blk)
#pragma unroll
                  for (int q4 = 0; q4 < 4; ++q4) { float s4 = 0.f, last = 0.f; const int n0 = 64 * j + 32 * blk + 8 * q4 + 4 * h;
#pragma unroll
                      for (int e = 0; e < 4; ++e) { const float sv = (blk ? S1 : S0)[4 * q4 + e]; const float p = (16 * (n0 + e) + 31 <= s) ? __builtin_amdgcn_exp2f(sv - m) * linv : 0.f; s4 += p; last = p; }
                      s4 += __shfl_xor(s4, 1); last += __shfl_xor(last, 1); s4 += __shfl_xor(s4, 2); last += __shfl_xor(last, 2); s4 += __shfl_xor(s4, 4); last += __shfl_xor(last, 4);
                      if ((c & 7) == 0) { LAS float* ip = imp + (wave * 4 + (c >> 3)) * 64 + (n0 >> 2);
                          __hip_atomic_fetch_add(ip, s4, __ATOMIC_RELAXED, __HIP_MEMORY_SCOPE_WORKGROUP);
                          if ((n0 >> 2) + 1 < 64) __hip_atomic_fetch_add(ip + 1, last, __ATOMIC_RELAXED, __HIP_MEMORY_SCOPE_WORKGROUP); } }
              __syncthreads();
          } }
        u64 mysel = 0ull;
#pragma unroll 1
        for (int tk = 0; tk < 4; ++tk) {
            const int j = lane; float sc = imp[(wave * 4 + tk) * 64 + j];
            sc = j > cur ? -3.0e38f : ((j == 0 || j == cur || j == cur - 1) ? 1.0e6f : sc);
            scr[wave * 64 + j] = sc;
            asm volatile("s_waitcnt lgkmcnt(0)" ::: "memory");
            int rank = 0;
#pragma unroll 4
            for (int jj = 0; jj <= cur; ++jj) { const float o = scr[wave * 64 + jj]; rank += (o > sc || (o == sc && jj < j)) ? 1 : 0; }
            const u64 bal = __ballot(j <= cur && rank < KSEL);
            if ((c >> 3) == tk) mysel = bal;
            asm volatile("s_waitcnt lgkmcnt(0)" ::: "memory");
        }
        m = NSA_NEG; l = 0.f;
        attn_branch<1>(KV + tb * NKVW + 256 + g * 64, KV + tb * NKVW + 384 + g * 64, NKVW, 0, cur + 1, 0, cur, KsB, VtB, qf, O, m, l, s, mysel, tid, c, h);
        { const float lt = l + __shfl_xor(l, 32); const float sc = lt > 0.f ? GT[t * 48 + hd * 3 + 1] / lt : 0.f;
#pragma unroll
          for (int i = 0; i < 16; ++i) { out[0][i] += O[0][i] * sc; out[1][i] += O[1][i] * sc; O[0][i] = 0.f; O[1][i] = 0.f; } }
        m = NSA_NEG; l = 0.f;
        { const int lo = s0 - (NWIN - 1); const int jlo = lo > 0 ? lo >> 6 : 0;
          const int jin = (s0 - 480 + 63) >> 6;
          attn_branch<2>(KV + tb * NKVW + 512 + g * 64, KV + tb * NKVW + 640 + g * 64, NKVW, jlo, cur + 1, jin > jlo ? jin : jlo, cur, KsB, VtB, qf, O, m, l, s, 0ull, tid, c, h); }
        { const float lt = l + __shfl_xor(l, 32); const float sc = lt > 0.f ? GT[t * 48 + hd * 3 + 2] / lt : 0.f;
#pragma unroll
          for (int db = 0; db < 2; ++db)
#pragma unroll
              for (int k2 = 0; k2 < 2; ++k2) { u32x2 w[2];
#pragma unroll
                  for (int qq = 0; qq < 2; ++qq) { const int q4 = 2 * k2 + qq; w[qq].x = cvtpk(out[db][4 * q4 + 0] + O[db][4 * q4 + 0] * sc, out[db][4 * q4 + 1] + O[db][4 * q4 + 1] * sc);
                      w[qq].y = cvtpk(out[db][4 * q4 + 2] + O[db][4 * q4 + 2] * sc, out[db][4 * q4 + 3] + O[db][4 * q4 + 3] * sc); }
                  const auto rx = __builtin_amdgcn_permlane32_swap(w[0].x, w[1].x, false, false), ry = __builtin_amdgcn_permlane32_swap(w[0].y, w[1].y, false, false);
                  *(u32x4*)(NO + t * D_ + hd * 64 + 32 * db + 16 * k2 + 8 * h) = (u32x4){rx[0], ry[0], rx[1], ry[1]}; } }
        __syncthreads();
    }
}


__device__ __forceinline__ f32x2_t bf2x(unsigned p) { return (f32x2_t){bits_f32(p << 16), bits_f32(p & 0xffff0000u)}; }
__device__ __forceinline__ void mod_fast(const Ctx& C, LAS unsigned char* lds) {
    int tid_ = threadIdx.x; asm volatile("" : "+v"(tid_)); const int tid = tid_, lane = tid & 63, wave = tid >> 6;
    LAS float* sc = (LAS float*)lds;
    LAS float* red = sc + NB * D_;
    for (int i = tid; i < NB * D_; i += NTHREADS) sc[i] = siluf_(C.f(I_C)[i]);
    __syncthreads();
    const int nitems = DEPTH * (6 * D_ / 128);
    for (int it = blockIdx.x; it < nitems; it += gridDim.x) {
        const int l = it / (6 * D_ / 128), j0 = (it % (6 * D_ / 128)) * 128;
        const float* W = C.f(I_ADA_W) + (size_t)l * D_ * 6 * D_ + j0 + 2 * lane;
        f32x2_t acc[NB];
#pragma unroll
        for (int b = 0; b < NB; ++b) acc[b] = (f32x2_t){0.f, 0.f};
#pragma unroll 8
        for (int kk = 0; kk < 128; ++kk) { const int k = wave * 128 + kk; const f32x2_t w = *(const f32x2_t*)(W + (size_t)k * 6 * D_);
#pragma unroll
            for (int b = 0; b < NB; ++b) acc[b] += w * sc[b * D_ + k]; }
#pragma unroll
        for (int b = 0; b < NB; ++b) *(LAS f32x2_t*)(red + (wave * NB + b) * 128 + 2 * lane) = acc[b];
        __syncthreads();
        for (int o = tid; o < NB * 128; o += NTHREADS) { const int b = o >> 7, j = o & 127; float a = C.f(I_ADA_B)[l * 6 * D_ + j0 + j];
#pragma unroll
            for (int w = 0; w < 8; ++w) a += red[(w * NB + b) * 128 + j];
            C.w<float>(WS_MOD)[(size_t)(l * NB + b) * 6 * D_ + j0 + j] = a; }
        __syncthreads();
    }
}
__device__ __forceinline__ void cb_fast(const Ctx& C, LAS unsigned char* lds) {
    int tid_ = threadIdx.x; asm volatile("" : "+v"(tid_)); const int tid = tid_, j = tid & 31, ig = tid >> 5; LAS float* red = (LAS float*)lds;
    for (int it = (int)gridDim.x - 1 - (int)blockIdx.x; it < 16; it += gridDim.x) {
        const int tz = it >> 3, j0 = (it & 7) * 32;
        const float* pe = C.f(tz ? I_NSA_POS_V : I_NSA_POS_K) + ig * 128; const float* w1 = C.f(tz ? I_NSA_V_W1 : I_NSA_K_W1) + (size_t)ig * 128 * 256 + j0 + j;
        float a = 0.f;
#pragma unroll 8
        for (int i = 0; i < 128; ++i) a += pe[i] * w1[(size_t)i * 256];
        red[ig * 32 + j] = a;
        __syncthreads();
        if (tid < 32) { float t = 0.f;
#pragma unroll
            for (int g = 0; g < 16; ++g) t += red[g * 32 + tid];
            C.w<float>(WS_CB)[tz * 256 + j0 + tid] = t; }
        __syncthreads();
    }
}
__device__ __forceinline__ void sincos_f32(float x, float& s, float& c) {
    const float kq = rintf(x * 0.6366197723675814f);
    float y = fmaf(-kq, 1.5703125f, x); y = fmaf(-kq, 4.837512969970703125e-4f, y); y = fmaf(-kq, 7.54978995489188e-8f, y);
    const int q = (int)kq & 3; const float z = y * y;
    const float sp = y + y * z * (-1.6666654611e-1f + z * (8.3321608736e-3f + z * (-1.9515295891e-4f)));
    const float cp = 1.0f - 0.5f * z + z * z * (4.166664568298827e-2f + z * (-1.388731625493765e-3f + z * 2.443315711809948e-5f));
    if (q == 0) { s = sp; c = cp; } else if (q == 1) { s = cp; c = -sp; } else if (q == 2) { s = -sp; c = -cp; } else { s = -cp; c = sp; }
}
__device__ __forceinline__ void rope_tables(const Ctx& C) {
    const long gt = (long)blockIdx.x * NTHREADS + threadIdx.x, gs = (long)gridDim.x * NTHREADS;
    for (long it = gt; it < (long)T_ * 128; it += gs) {
        const int i = (int)(it / T_), t = (int)(it % T_);
        const float inv = exp2f(-(float)(2 * i) / 256.0f * 13.287712379549449f);
        const float ang = (float)C.pos()[t] * inv; float sn, cs; sincos_f32(ang, sn, cs);
        C.w<float>(WS_COS256T)[it] = cs; C.w<float>(WS_SIN256T)[it] = sn;
        C.w<float>(WS_COS256)[(size_t)t * 128 + i] = cs; C.w<float>(WS_SIN256)[(size_t)t * 128 + i] = sn;
    }
    for (long it = gt; it < (long)T_ * 32; it += gs) {
        const int t = (int)(it >> 5), i = (int)(it & 31);
        const float inv = exp2f(-(float)(2 * i) / 64.0f * 13.287712379549449f);
        const float ang = (float)C.pos()[t] * inv; float sn, cs; sincos_f32(ang, sn, cs);
        C.w<float>(WS_COS64)[it] = cs; C.w<float>(WS_SIN64)[it] = sn;
    }
}
__device__ __forceinline__ void modx0_fast(const Ctx& C) {
    const long gt = (long)blockIdx.x * NTHREADS + threadIdx.x, gs = (long)gridDim.x * NTHREADS;
    int bprev = -1; f32x4 s0 = {0.f, 0.f, 0.f, 0.f}, s1 = s0, h0 = s0, h1 = s0;
    for (long it = gt; it < (long)T_ * D_ / 8; it += gs) { const long e = it * 8; const int t = (int)(e / D_), c = (int)(e % D_), b = t / S_;
        const f32x4 x0 = *(const f32x4*)(C.f(I_X) + e), x1 = *(const f32x4*)(C.f(I_X) + e + 4);
        if (b != bprev) { s0 = *(const f32x4*)(C.mod(0, b, 1) + c); s1 = *(const f32x4*)(C.mod(0, b, 1) + c + 4); h0 = *(const f32x4*)(C.mod(0, b, 0) + c); h1 = *(const f32x4*)(C.mod(0, b, 0) + c + 4); bprev = b; }
        *(u32x4*)(C.w<bf16>(WS_H) + e) = pg8_pack8(x0 * (s0 + 1.0f) + h0, x1 * (s1 + 1.0f) + h1); }
}
__device__ __forceinline__ void ret_gn_fast(const Ctx& C) {
    const int lane = threadIdx.x & 63, wave = threadIdx.x >> 6;
    const bf16* z = C.w<bf16>(WS_QKVG); const bf16* O = C.w<bf16>(WS_RO); bf16* A2 = C.w<bf16>(WS_RA2);
    f32x4 gn_g0[RH], gn_g1[RH], gn_b0[RH], gn_b1[RH];
#pragma unroll
    for (int hh = 0; hh < RH; ++hh) { const float* gg = C.f(I_RET_GN_G) + hh * RDV + 8 * lane; const float* gb = C.f(I_RET_GN_B) + hh * RDV + 8 * lane;
        gn_g0[hh] = *(const f32x4*)gg; gn_g1[hh] = *(const f32x4*)(gg + 4); gn_b0[hh] = *(const f32x4*)gb; gn_b1[hh] = *(const f32x4*)(gb + 4); }
    for (long t = (long)blockIdx.x * 8 + wave; t < T_; t += (long)gridDim.x * 8) {
#pragma unroll
        for (int hh = 0; hh < RH; ++hh) {
            const u32x4 ov = *(const u32x4*)(O + (t * RH + hh) * RDV + 8 * lane), gv = *(const u32x4*)(z + t * RW + 2 * RH * RDK + RH * RDV + hh * RDV + 8 * lane);
            float o[8], g[8];
            { const f32x2_t a = bf2x(ov.x), b2 = bf2x(ov.y), c2 = bf2x(ov.z), d2 = bf2x(ov.w); o[0] = a.x; o[1] = a.y; o[2] = b2.x; o[3] = b2.y; o[4] = c2.x; o[5] = c2.y; o[6] = d2.x; o[7] = d2.y; }
            { const f32x2_t a = bf2x(gv.x), b2 = bf2x(gv.y), c2 = bf2x(gv.z), d2 = bf2x(gv.w); g[0] = a.x; g[1] = a.y; g[2] = b2.x; g[3] = b2.y; g[4] = c2.x; g[5] = c2.y; g[6] = d2.x; g[7] = d2.y; }
            float sm = 0.f;
#pragma unroll
            for (int e = 0; e < 8; ++e) sm += o[e];
            const float mu = wave_sum(sm) * (1.0f / RDV); float q = 0.f;
#pragma unroll
            for (int e = 0; e < 8; ++e) { o[e] -= mu; q += o[e] * o[e]; }
            const float rstd = __builtin_amdgcn_rsqf(wave_sum(q) * (1.0f / RDV) + LN_EPS);
            const f32x4 g0 = gn_g0[hh], g1 = gn_g1[hh], b0 = gn_b0[hh], b1 = gn_b1[hh];
            f32x4 r0, r1;
#pragma unroll
            for (int e = 0; e < 4; ++e) { r0[e] = g[e] * fast_sigmoid(g[e]) * (o[e] * rstd * g0[e] + b0[e]); r1[e] = g[4 + e] * fast_sigmoid(g[4 + e]) * (o[4 + e] * rstd * g1[e] + b1[e]); }
            *(u32x4*)(A2 + (t * RH + hh) * RDV + 8 * lane) = pg8_pack8(r0, r1);
        }
    }
}
template <int R> struct ConvRow { static __device__ __forceinline__ void run(f32x2_t (&acc)[32], const f32x2_t (&wd)[CW], const LAS unsigned* st) {
    const f32x2_t u = bf2x(st[R * 512]);
#pragma unroll
    for (int t = 0; t < 32; ++t) if (R - t >= 0 && R - t < CW) acc[t] += u * wd[(R - t >= 0 && R - t < CW) ? R - t : 0];
    ConvRow<R + 1>::run(acc, wd, st); } };
template <> struct ConvRow<62> { static __device__ __forceinline__ void run(f32x2_t (&)[32], const f32x2_t (&)[CW], const LAS unsigned*) {} };
__device__ __forceinline__ void conv_fast(const Ctx& C, LAS unsigned char* lds) {
    int tid_ = threadIdx.x; asm volatile("" : "+v"(tid_)); const int tid = tid_, lane = tid & 63, wave = tid >> 6;
    const bf16* U = C.w<bf16>(WS_CU); bf16* A2 = C.w<bf16>(WS_CA2);
    LAS unsigned* st = (LAS unsigned*)lds;
    LAS float* of = (LAS float*)lds;
    f32x2_t wd[CW];
#pragma unroll
    for (int w = 0; w < CW; ++w) wd[w] = *(const f32x2_t*)(C.f(I_CONV_W_DW) + w * D_ + 2 * tid);
    const f32x2_t bd = *(const f32x2_t*)(C.f(I_CONV_B_DW) + 2 * tid);
    for (int unit = blockIdx.x; unit < T_ / 32; unit += gridDim.x) {
        const long t0 = (long)unit * 32; const int s0 = (int)(t0 % S_);
        for (int i = tid; i < 62 * 128; i += NTHREADS) { const int r = i >> 7, ch = i & 127; const int sp = s0 - 30 + r;
            u32x4 v = (u32x4){0u, 0u, 0u, 0u}; if (sp >= 0) v = *(const u32x4*)(U + (t0 - 30 + r) * D_ + 8 * ch);
            *(LAS u32x4*)(st + r * 512 + 4 * ch) = v; }
        __syncthreads();
        f32x2_t acc[32];
#pragma unroll
        for (int t = 0; t < 32; ++t) acc[t] = bd;
        ConvRow<0>::run(acc, wd, st + tid);
        __syncthreads();
#pragma unroll
        for (int t = 0; t < 32; ++t) *(LAS f32x2_t*)(of + t * D_ + 2 * tid) = acc[t];
        __syncthreads();
#pragma unroll
        for (int rr = 0; rr < 4; ++rr) { const int r = wave * 4 + rr; f32x4 v[4]; float sm = 0.f;
#pragma unroll
            for (int j = 0; j < 4; ++j) { v[j] = *(const LAS f32x4*)(of + r * D_ + 4 * lane + 256 * j); sm += (v[j][0] + v[j][1]) + (v[j][2] + v[j][3]); }
            const float mu = wave_sum(sm) * (1.0f / D_); float q = 0.f;
#pragma unroll
            for (int j = 0; j < 4; ++j) { v[j] = v[j] - mu; q += (v[j][0] * v[j][0] + v[j][1] * v[j][1]) + (v[j][2] * v[j][2] + v[j][3] * v[j][3]); }
            const float rstd = __builtin_amdgcn_rsqf(wave_sum(q) * (1.0f / D_) + LN_EPS);
#pragma unroll
            for (int j = 0; j < 4; ++j) { f32x4 y = v[j] * rstd * *(const f32x4*)(C.f(I_CONV_LN_G) + 4 * lane + 256 * j) + *(const f32x4*)(C.f(I_CONV_LN_B) + 4 * lane + 256 * j);
#pragma unroll
                for (int e = 0; e < 4; ++e) y[e] = y[e] * fast_sigmoid(y[e]);
                u32x2 p; p.x = cvt_pk_bf16(y[0], y[1]); p.y = cvt_pk_bf16(y[2], y[3]); *(u32x2*)(A2 + (t0 + r) * D_ + 4 * lane + 256 * j) = p; } }
        __syncthreads();
    }
}
__device__ __forceinline__ void pool_fast(const Ctx& C, LAS unsigned char* lds) {
    const int tid = threadIdx.x; const bf16* H = C.w<bf16>(WS_H); bf16* PL = C.w<bf16>(WS_PL);
    LAS unsigned* st = (LAS unsigned*)lds;
    const int win = 2 << (tid >> 7);
    for (int unit = blockIdx.x; unit < T_ / 32; unit += gridDim.x) {
        const long t0 = (long)unit * 32; const int s0 = (int)(t0 % S_);
#pragma unroll
        for (int kb = 0; kb < 12; kb += 6) { u32x4 sv[6];
#pragma unroll
          for (int k = 0; k < 6; ++k) { const int i = tid + (kb + k) * NTHREADS, r = i >> 7, ch = i & 127; const int sp = s0 - 15 + r;
              sv[k] = (u32x4){0u, 0u, 0u, 0u}; if (i < 47 * 128 && sp >= 0) sv[k] = *(const u32x4*)(H + (t0 - 15 + r) * D_ + 8 * ch); }
#pragma unroll
          for (int k = 0; k < 6; ++k) { const int i = tid + (kb + k) * NTHREADS, r = i >> 7, ch = i & 127; if (i < 47 * 128) *(LAS u32x4*)(st + r * 512 + 4 * ch) = sv[k]; } }
        __syncthreads();
        f32x2_t sum = (f32x2_t){0.f, 0.f};
        for (int w = 1; w < win; ++w) sum += bf2x(st[(15 - w) * 512 + tid]);
#pragma unroll 4
        for (int t = 0; t < 32; ++t) { const f32x2_t hv = bf2x(st[(15 + t) * 512 + tid]); sum += hv;
            const int s = s0 + t; const int cnt = s + 1 < win ? s + 1 : win;
            const f32x2_t o = sum * (1.0f / (float)cnt) - hv;
            *(unsigned*)(PL + (t0 + t) * D_ + 2 * tid) = cvt_pk_bf16(o.x, o.y);
            sum -= bf2x(st[(15 + t - win + 1) * 512 + tid]); }
        __syncthreads();
    }
}


constexpr int RC = 32;
constexpr int RQ_LD = 264, RKT_LD = 40, RST_LD = 264;
__device__ __forceinline__ void ret_core_fast(const Ctx& C, LAS unsigned char* lds) {
    int tid_ = threadIdx.x; asm volatile("" : "+v"(tid_)); const int tid = tid_, lane = tid & 63, wave = __builtin_amdgcn_readfirstlane(tid >> 6), c = lane & 31, hh = lane >> 5;
    LAS bf16* Qs = (LAS bf16*)lds; LAS bf16* Ks = Qs + 32 * RQ_LD; LAS bf16* KTs = Ks + 32 * RQ_LD; LAS bf16* VP = KTs + 256 * RKT_LD; LAS bf16* VD = VP + 64 * RKT_LD;
    LAS bf16* ST = VD + 64 * RKT_LD; LAS float* XCH = (LAS float*)(ST + 64 * RST_LD);
    const bf16* z = C.w<bf16>(WS_QKVG); const bf16* KTg = C.w<bf16>(WS_KT); const bf16* VTg = C.w<bf16>(WS_VT); bf16* RO = C.w<bf16>(WS_RO);
    for (int unit = blockIdx.x; unit < NB * RH * 8; unit += gridDim.x) {
        const int vs = (unit >> 3) & 7, bh = (unit & 7) * 4 + (unit >> 6), h = bh % RH, b = bh / RH; const size_t tb = (size_t)b * S_;
        const float lg2 = log2f(1.0f - exp2f(-5.0f - (float)h));
        for (int i = tid; i < 64 * RST_LD / 2; i += NTHREADS) ((LAS unsigned*)ST)[i] = 0u;
        u32x4 rq0[2], rk0[2], rv0, rq1[2], rk1[2], rv1;
#define RET_LOAD(ch, S) do { const size_t t0_ = tb + (size_t)(ch) * RC; \
        _Pragma("unroll") for (int i_ = 0; i_ < 2; ++i_) { const int p_ = tid + i_ * NTHREADS, r_ = p_ >> 5, cc_ = p_ & 31; \
            rq##S[i_] = *(const u32x4*)(z + (t0_ + r_) * RW + h * RDK + 8 * cc_); rk##S[i_] = *(const u32x4*)(z + (t0_ + r_) * RW + RH * RDK + h * RDK + 8 * cc_); \
            } \
        if (tid < 256) rv##S = *(const u32x4*)(VTg + ((size_t)h * RDV + vs * 64 + (tid >> 2)) * T_ + t0_ + 8 * (tid & 3)); } while (0)
#define RET_STORE(S) do { \
        _Pragma("unroll") for (int i_ = 0; i_ < 2; ++i_) { const int p_ = tid + i_ * NTHREADS, r_ = p_ >> 5, cc_ = p_ & 31; \
            *(LAS u32x4*)(Qs + r_ * RQ_LD + 8 * cc_) = rq##S[i_]; *(LAS u32x4*)(Ks + r_ * RQ_LD + 8 * cc_) = rk##S[i_]; \
            } \
        if (tid < 256) { const int v_ = tid >> 2, q_ = tid & 3;       \
            const int g0_ = 2 * q_, g1_ = 2 * q_ + 1; \
            const int p0_ = (g0_ & ~3) | ((g0_ & 3) == 1 ? 2 : (g0_ & 3) == 2 ? 1 : (g0_ & 3)), p1_ = (g1_ & ~3) | ((g1_ & 3) == 1 ? 2 : (g1_ & 3) == 2 ? 1 : (g1_ & 3)); \
            *(LAS u32x2*)(VP + v_ * RKT_LD + 4 * p0_) = (u32x2){rv##S.x, rv##S.y}; *(LAS u32x2*)(VP + v_ * RKT_LD + 4 * p1_) = (u32x2){rv##S.z, rv##S.w}; \
            const f32x2_t a_ = bf2x(rv##S.x), b_ = bf2x(rv##S.y), c_ = bf2x(rv##S.z), d2_ = bf2x(rv##S.w); u32x4 w_; \
            w_.x = cvtpk(a_.x * vdec[0], a_.y * vdec[1]); w_.y = cvtpk(b_.x * vdec[2], b_.y * vdec[3]); \
            w_.z = cvtpk(c_.x * vdec[4], c_.y * vdec[5]); w_.w = cvtpk(d2_.x * vdec[6], d2_.y * vdec[7]); \
            *(LAS u32x4*)(VD + v_ * RKT_LD + 8 * q_) = w_; } } while (0)
        float vdec[8];
#pragma unroll
        for (int k = 0; k < 8; ++k) vdec[k] = __builtin_amdgcn_exp2f(lg2 * (float)(RC - 1 - 8 * (tid & 3) - k));
        RET_LOAD(0, 0); RET_STORE(0); RET_LOAD(1, 1);
        __syncthreads();
        f32x16 Sm[2];
#pragma unroll
        for (int k = 0; k < 2; ++k)
#pragma unroll
            for (int i = 0; i < 16; ++i) Sm[k][i] = 0.f;
        const float dchunk = __builtin_amdgcn_exp2f(lg2 * (float)RC);
        f32x16 dmask;
#pragma unroll
        for (int i = 0; i < 16; ++i) { const int j = crow32(i, hh); dmask[i] = j <= c ? __builtin_amdgcn_exp2f(lg2 * (float)(c - j)) : 0.f; }
        const float dq = __builtin_amdgcn_exp2f(lg2 * (float)(c + 1));
        constexpr int NCHK = S_ / RC;
#pragma unroll 2
        for (int ch = 0; ch < NCHK; ++ch) {
            if (ch + 2 < NCHK) { if ((ch & 1) == 0) RET_LOAD(ch + 2, 0); else RET_LOAD(ch + 2, 1); }
            f32x16 Oi[2];
            if (wave == 0) {
                f32x16 St;
#pragma unroll
                for (int i = 0; i < 16; ++i) St[i] = 0.f;
#pragma unroll 4
                for (int sx = 0; sx < 16; ++sx) { const bf16x8 a0 = *(const LAS bf16x8*)(Ks + c * RQ_LD + 16 * sx + 8 * hh), q0 = *(const LAS bf16x8*)(Qs + c * RQ_LD + 16 * sx + 8 * hh);
                    St = __builtin_amdgcn_mfma_f32_32x32x16_bf16(a0, q0, St, 0, 0, 0); }
#pragma unroll
                for (int i = 0; i < 16; ++i) St[i] *= dmask[i];
#pragma unroll
                for (int vb = 0; vb < 2; ++vb) {
#pragma unroll
                    for (int i = 0; i < 16; ++i) Oi[vb][i] = 0.f;
#pragma unroll
                    for (int ks = 0; ks < 2; ++ks) { u32x4 pw; pw.x = cvtpk(St[8 * ks + 0], St[8 * ks + 1]); pw.y = cvtpk(St[8 * ks + 2], St[8 * ks + 3]); pw.z = cvtpk(St[8 * ks + 4], St[8 * ks + 5]); pw.w = cvtpk(St[8 * ks + 6], St[8 * ks + 7]);
                        const bf16x8 a = *(const LAS bf16x8*)(VP + (32 * vb + c) * RKT_LD + 16 * ks + 8 * hh);
                        Oi[vb] = __builtin_amdgcn_mfma_f32_32x32x16_bf16(a, __builtin_bit_cast(bf16x8, pw), Oi[vb], 0, 0, 0); } }
            } else if (wave < 3) {
                const int vb = wave - 1; f32x16 Oc;
#pragma unroll
                for (int i = 0; i < 16; ++i) Oc[i] = 0.f;
#pragma unroll 4
                for (int sx = 0; sx < 16; ++sx) { const bf16x8 a0 = *(const LAS bf16x8*)(ST + (32 * vb + c) * RST_LD + 16 * sx + 8 * hh), q0 = *(const LAS bf16x8*)(Qs + c * RQ_LD + 16 * sx + 8 * hh);
                    Oc = __builtin_amdgcn_mfma_f32_32x32x16_bf16(a0, q0, Oc, 0, 0, 0); }
#pragma unroll
                for (int i = 0; i < 16; ++i) XCH[(vb * 16 + i) * 64 + lane] = Oc[i];
            }
            bf16x8 kta[2];
#pragma unroll
            for (int ks = 0; ks < 2; ++ks)
#pragma unroll
                for (int jj = 0; jj < 8; ++jj) kta[ks][jj] = (short)Ks[(16 * ks + 8 * hh + jj) * RQ_LD + 32 * wave + c];
#pragma unroll
            for (int vb = 0; vb < 2; ++vb) {
#pragma unroll
                for (int i = 0; i < 16; ++i) Sm[vb][i] *= dchunk;
#pragma unroll
                for (int ks = 0; ks < 2; ++ks) { const bf16x8 bv = *(const LAS bf16x8*)(VD + (32 * vb + c) * RKT_LD + 16 * ks + 8 * hh);
                    Sm[vb] = __builtin_amdgcn_mfma_f32_32x32x16_bf16(kta[ks], bv, Sm[vb], 0, 0, 0); } }
            __syncthreads();
            if (ch + 1 < NCHK) { if ((ch & 1) == 0) RET_STORE(1); else RET_STORE(0); }
            if (wave == 0) {
                const size_t t = tb + (size_t)ch * RC + c;
#pragma unroll
                for (int vb = 0; vb < 2; ++vb)
#pragma unroll
                    for (int k2 = 0; k2 < 2; ++k2) { u32x2 w[2];
#pragma unroll
                        for (int qq = 0; qq < 2; ++qq) { const int q4 = 2 * k2 + qq; float o[4];
#pragma unroll
                            for (int e = 0; e < 4; ++e) o[e] = Oi[vb][4 * q4 + e] + dq * XCH[(vb * 16 + 4 * q4 + e) * 64 + lane];
                            w[qq].x = cvtpk(o[0], o[1]); w[qq].y = cvtpk(o[2], o[3]); }
                        const auto rx = __builtin_amdgcn_permlane32_swap(w[0].x, w[1].x, false, false), ry = __builtin_amdgcn_permlane32_swap(w[0].y, w[1].y, false, false);
                        *(u32x4*)(RO + t * (RH * RDV) + h * RDV + vs * 64 + 32 * vb + 16 * k2 + 8 * hh) = (u32x4){rx[0], ry[0], rx[1], ry[1]}; }
            }
#pragma unroll
            for (int vb = 0; vb < 2; ++vb)
#pragma unroll
                for (int q4 = 0; q4 < 4; ++q4) { u32x2 w; w.x = cvtpk(Sm[vb][4 * q4 + 0], Sm[vb][4 * q4 + 1]); w.y = cvtpk(Sm[vb][4 * q4 + 2], Sm[vb][4 * q4 + 3]);
                    *(LAS u32x2*)(ST + (32 * vb + c) * RST_LD + 32 * wave + 8 * q4 + 4 * hh) = w; }
            __syncthreads();
        }
#undef RET_LOAD
#undef RET_STORE
    }
}

namespace pg8 {
constexpr int BM = 256, BK = 64, HALF = 128, HTB = HALF * BK * 2, STAGE_BYTES = 8 * HTB;
__device__ __forceinline__ int lds_byte(int r, int c) { const int st = (r >> 4) * 2 + (c >> 5), rr = r & 15, cc = c & 31, ob = rr * 64 + cc * 2; return st * 1024 + (ob ^ (((ob >> 9) & 1) << 5)); }
__device__ __forceinline__ void stage_rc(int b, int& R, int& Cc) { const int st = b / 1024, sb = b % 1024, swz = sb ^ (((sb >> 9) & 1) << 5); R = (st >> 1) * 16 + swz / 64; Cc = (st & 1) * 32 + (swz % 64) / 2; }
__device__ __forceinline__ int perm32(int rho) { const int n = rho >> 4, i = rho & 15; return 8 * (i >> 2) + 4 * n + (i & 3); }
struct Unit { const char* A; const char* B; int pm, pn, z, nrows, aux; };
struct GemmP { int K; unsigned ldb_b, kstepA; int kwrap = 0; };
typedef f32x4 Acc[2][2][4][2];

typedef int v4i __attribute__((ext_vector_type(4)));
typedef int v8i __attribute__((ext_vector_type(8)));
template <class Epi, class Sched, bool ALIGN_EPI, bool FP8 = false>
__device__ __forceinline__ void gemm8(LAS unsigned char* lds, const GemmP P, const Sched& S, const Epi& E) {
    int tid_ = threadIdx.x; asm volatile("" : "+v"(tid_)); const int tid = tid_, wid = __builtin_amdgcn_readfirstlane(tid >> 6), lane = tid & 63, wr = wid >> 2, wc = wid & 3, fr = lane & 15, fq = lane >> 4;
    int nt = P.K / BK; asm volatile("" : "+s"(nt));
    int Rr[2], Cb[2]; unsigned voffB[2];
#pragma unroll
    for (int i = 0; i < 2; ++i) { int R, Cc; stage_rc(tid * 16 + i * 8192, R, Cc); Rr[i] = R; Cb[i] = Cc * 2; const int Rb = (R & ~31) + perm32(R & 31); voffB[i] = (unsigned)Rb * P.ldb_b + (unsigned)Cc * 2u; }
    const size_t kstepA = P.kstepA, kstepB = BK * 2, hstepB = (size_t)HALF * P.ldb_b;
    const unsigned ldsw = (unsigned)wid * 1024u;
    const int aoff = lds_byte(wr * 64 + fr, fq * 8), boff = lds_byte(wc * 32 + fr, fq * 8);
#define PG8_SA(b, h) (((b) * 2 + (h)) * HTB)
#define PG8_SB(b, h) ((4 + (b) * 2 + (h)) * HTB)
#define PG8_STAGE(bufoff, gbase, voff) do { _Pragma("unroll") for (int _i = 0; _i < 2; ++_i) \
        __builtin_amdgcn_global_load_lds((const unsigned*)((const char*)(gbase) + (voff)[_i]), (LAS unsigned*)(lds + (bufoff) + ldsw + _i * 8192), 16, 0, 0); } while (0)
#define PG8_LDA(dst, b, h) do { if constexpr (FP8) { _Pragma("unroll") for (int m = 0; m < 4; ++m) { const v4i l0_ = *(const LAS v4i*)(lds + PG8_SA(b, h) + aoff + m * 2048), l1_ = *(const LAS v4i*)(lds + PG8_SA(b, h) + aoff + m * 2048 + 1024); \
        dst##8[m] = __builtin_shufflevector(l0_, l1_, 0, 1, 2, 3, 4, 5, 6, 7); } } else { \
        _Pragma("unroll") for (int m = 0; m < 4; ++m) _Pragma("unroll") for (int k = 0; k < 2; ++k) dst[m][k] = *(const LAS bf16x8*)(lds + PG8_SA(b, h) + aoff + m * 2048 + k * 1024); } } while (0)
#define PG8_LDB(dst, b, h) do { if constexpr (FP8) { _Pragma("unroll") for (int n = 0; n < 2; ++n) { const v4i l0_ = *(const LAS v4i*)(lds + PG8_SB(b, h) + boff + n * 2048), l1_ = *(const LAS v4i*)(lds + PG8_SB(b, h) + boff + n * 2048 + 1024); \
        dst##8[n] = __builtin_shufflevector(l0_, l1_, 0, 1, 2, 3, 4, 5, 6, 7); } } else { \
        _Pragma("unroll") for (int n = 0; n < 2; ++n) _Pragma("unroll") for (int k = 0; k < 2; ++k) dst[n][k] = *(const LAS bf16x8*)(lds + PG8_SB(b, h) + boff + n * 2048 + k * 1024); } } while (0)
#define PG8_MMA(ai, bj, At, Bt) do { __builtin_amdgcn_s_setprio(1); if constexpr (FP8) { _Pragma("unroll") for (int m = 0; m < 4; ++m) _Pragma("unroll") for (int n = 0; n < 2; ++n) \
        acc[ai][bj][m][n] = __builtin_amdgcn_mfma_scale_f32_16x16x128_f8f6f4(Bt##8[n], At##8[m], acc[ai][bj][m][n], 0, 0, 0, 0x7f7f7f7f, 0, 0x7f7f7f7f); } else { \
        _Pragma("unroll") for (int m = 0; m < 4; ++m) _Pragma("unroll") for (int n = 0; n < 2; ++n) _Pragma("unroll") for (int k = 0; k < 2; ++k) \
        acc[ai][bj][m][n] = __builtin_amdgcn_mfma_f32_16x16x32_bf16(Bt[n][k], At[m][k], acc[ai][bj][m][n], 0, 0, 0); } __builtin_amdgcn_s_setprio(0); } while (0)
#define PG8_WAIT_V(n) asm volatile("s_waitcnt vmcnt(" #n ")" ::: "memory")
#define PG8_WAIT_L(n) asm volatile("s_waitcnt lgkmcnt(" #n ")" ::: "memory")
#define PG8_BAR __builtin_amdgcn_s_barrier()
#define PG8_SCHED __builtin_amdgcn_sched_barrier(0)
#define PG8_ROWOFFS(u, v) do { _Pragma("unroll") for (int _h = 0; _h < 2; ++_h) _Pragma("unroll") for (int _i = 0; _i < 2; ++_i) { unsigned _o = S.row_off(u, _h * 128 + Rr[_i]) + (unsigned)Cb[_i]; asm volatile("" : "+v"(_o)); v[_h][_i] = _o;     } } while (0)
#define PG8_ROWIDX(u, p) do { _Pragma("unroll") for (int _h = 0; _h < 2; ++_h) _Pragma("unroll") for (int _i = 0; _i < 2; ++_i) p[_h][_i] = S.row_idx(u, _h * 128 + Rr[_i]); } while (0)
    Unit cur, nxt; int ui = 0;
    if (!S.next(0, cur)) return;
    Acc acc;
#pragma unroll
    for (int a = 0; a < 2; ++a)
#pragma unroll
        for (int b = 0; b < 2; ++b)
#pragma unroll
            for (int m = 0; m < 4; ++m)
#pragma unroll
                for (int n = 0; n < 2; ++n) acc[a][b][m][n] = (f32x4){0.f, 0.f, 0.f, 0.f};
    bf16x8 At[4][2], B0[2][2], B1[2][2];
    v8i At8[4], B08[2], B18[2];
    (void)At; (void)B0; (void)B1; (void)At8; (void)B08; (void)B18;
    unsigned va[2][2], na[2][2]; int pend[2][2] = {{0, 0}, {0, 0}};
    PG8_ROWOFFS(cur, va);
    if constexpr (Sched::GATHER) { Unit n1, n2; if (S.next(1, n1)) { PG8_ROWOFFS(n1, na); } else {
#pragma unroll
            for (int h = 0; h < 2; ++h)
#pragma unroll
                for (int i = 0; i < 2; ++i) na[h][i] = va[h][i]; }
        if (S.next(2, n2)) PG8_ROWIDX(n2, pend); }
    float epf = 0.f; if constexpr (Epi::HAS_PRE) epf = E.pre(cur, tid);
    LAS float* const prebuf = (LAS float*)(lds + 133120);
    const char* cA = cur.A; const char* cB = cur.B;
    PG8_STAGE(PG8_SB(0, 0), cB, voffB); PG8_STAGE(PG8_SB(0, 1), cB + hstepB, voffB); PG8_STAGE(PG8_SA(0, 0), cA, va[0]); PG8_STAGE(PG8_SA(0, 1), cA, va[1]);
    if (wr == 1) PG8_BAR;
    PG8_WAIT_V(2); PG8_BAR;
    PG8_STAGE(PG8_SB(1, 0), cB + kstepB, voffB); PG8_STAGE(PG8_SA(1, 0), cA + kstepA, va[0]); PG8_STAGE(PG8_SB(1, 1), cB + hstepB + kstepB, voffB);
    PG8_WAIT_V(6); PG8_BAR;
    for (;;) {
        const bool has_next = S.next(ui + 1, nxt);
        const char* nA = has_next ? nxt.A : cA; const char* nB = has_next ? nxt.B : cB;
        if constexpr (!Sched::GATHER) {
            if (has_next) { PG8_ROWOFFS(nxt, na); } else {
#pragma unroll
                for (int h = 0; h < 2; ++h)
#pragma unroll
                    for (int i = 0; i < 2; ++i) na[h][i] = va[h][i]; } }
        for (int t = 0; t < nt; t += 2) {
            const bool last = (t == nt - 2);
            const int w1_ = P.kwrap ? (t + 1) % P.kwrap : t + 1, w2_ = P.kwrap ? (t + 2) % P.kwrap : t + 2;
            const char* a1 = cA + (size_t)w1_ * kstepA;
            const char* a2 = last ? nA : cA + (size_t)w2_ * kstepA; const char* b2 = last ? nB : cB + (size_t)w2_ * kstepB;
            const char* a3 = a2 + kstepA; const char* b3 = b2 + kstepB;
            PG8_LDB(B0, 0, 0); PG8_LDB(B1, 0, 1); PG8_SCHED; PG8_LDA(At, 0, 0); PG8_STAGE(PG8_SA(1, 1), a1, va[1]);
            if (last) {
#pragma unroll
                for (int h = 0; h < 2; ++h)
#pragma unroll
                    for (int i = 0; i < 2; ++i) va[h][i] = na[h][i]; }
            PG8_WAIT_V(8); PG8_WAIT_L(0); PG8_BAR; PG8_MMA(0, 0, At, B0); PG8_MMA(0, 1, At, B1); PG8_BAR; PG8_SCHED;
            PG8_LDA(At, 0, 1); PG8_STAGE(PG8_SB(0, 0), b2, voffB); PG8_STAGE(PG8_SB(0, 1), b2 + hstepB, voffB); PG8_STAGE(PG8_SA(0, 0), a2, va[0]);
            PG8_WAIT_V(8); PG8_WAIT_L(0); PG8_BAR; PG8_MMA(1, 0, At, B0); PG8_MMA(1, 1, At, B1); PG8_BAR; PG8_SCHED;
            PG8_LDB(B0, 1, 0); PG8_LDB(B1, 1, 1); PG8_SCHED; PG8_LDA(At, 1, 0); PG8_STAGE(PG8_SA(0, 1), a2, va[1]);
            PG8_WAIT_V(8); PG8_WAIT_L(0); PG8_BAR; PG8_MMA(0, 0, At, B0); PG8_MMA(0, 1, At, B1); PG8_BAR; PG8_SCHED;
            PG8_LDA(At, 1, 1); PG8_STAGE(PG8_SB(1, 0), b3, voffB); PG8_STAGE(PG8_SB(1, 1), b3 + hstepB, voffB); PG8_STAGE(PG8_SA(1, 0), a3, va[0]);
            PG8_WAIT_V(8); PG8_WAIT_L(0); PG8_BAR; PG8_MMA(1, 0, At, B0); PG8_MMA(1, 1, At, B1); PG8_BAR; PG8_SCHED;
        }
        if constexpr (Sched::GATHER) { Unit n2, n3;
            if (S.next(ui + 2, n2)) {
#pragma unroll
                for (int h = 0; h < 2; ++h)
#pragma unroll
                    for (int i = 0; i < 2; ++i) { unsigned o = S.idx_off(pend[h][i]) + (unsigned)Cb[i]; asm volatile("" : "+v"(o)); na[h][i] = o; } }
            if (S.next(ui + 3, n3)) PG8_ROWIDX(n3, pend); }
        float epf_n = 0.f; if constexpr (Epi::HAS_PRE) { if (has_next) epf_n = E.pre(nxt, tid); }
        if constexpr (ALIGN_EPI) { if (wr == 0) PG8_BAR; }
        if constexpr (Epi::HAS_PRE) { static_assert(ALIGN_EPI, "the LDS bias hand-off needs both half-workgroups aligned");
            if (tid < 256) prebuf[tid] = epf; PG8_WAIT_L(0); PG8_BAR; epf = epf_n; }
        { int fr_ = fr, fq_ = fq; asm volatile("" : "+v"(fr_), "+v"(fq_));
          if constexpr (Epi::HAS_PRE) { E(acc, cur, wr, wc, fr_, fq_, prebuf); if (PROBE_KIND == 11) { asm volatile("" : "+v"(fr_)); E(acc, cur, wr, wc, fr_, fq_, prebuf); } } else E(acc, cur, wr, wc, fr_, fq_); }
        if (!has_next) break;
#pragma unroll
        for (int a = 0; a < 2; ++a)
#pragma unroll
            for (int b = 0; b < 2; ++b)
#pragma unroll
                for (int m = 0; m < 4; ++m)
#pragma unroll
                    for (int n = 0; n < 2; ++n) acc[a][b][m][n] = (f32x4){0.f, 0.f, 0.f, 0.f};
        cur = nxt; cA = nA; cB = nB; ++ui;
        if constexpr (ALIGN_EPI) { if (wr == 1) PG8_BAR; }
    }
    PG8_WAIT_V(0);
    if constexpr (!ALIGN_EPI) { if (wr == 0) PG8_BAR; }
    PG8_BAR;
#undef PG8_SA
#undef PG8_SB
#undef PG8_STAGE
#undef PG8_LDA
#undef PG8_LDB
#undef PG8_MMA
#undef PG8_WAIT_V
#undef PG8_WAIT_L
#undef PG8_BAR
#undef PG8_SCHED
#undef PG8_ROWOFFS
#undef PG8_ROWIDX
}

struct DenseSched {           static constexpr bool GATHER = false;
    const char* A0; const char* B0; unsigned lda_b; size_t a_pn_b, b_pn_b; int nM, nN, nwg, G, c;
    __device__ __forceinline__ void init(const void* A, unsigned lda_bytes, const void* B, size_t b_pn_bytes, int M, int N, size_t a_pn_bytes = 0) {
        A0 = (const char*)A; B0 = (const char*)B; lda_b = lda_bytes; a_pn_b = a_pn_bytes; b_pn_b = b_pn_bytes; nM = M / 256; nN = N / 256; nwg = nM * nN; G = gridDim.x; c = blockIdx.x; }
    __device__ __forceinline__ bool next(int i, Unit& u) const {
        const long L = (long)i * G + c; if (L >= nwg) return false;
        int wgid = (int)L; { const int q = nwg / 8, r = nwg % 8, xcd = wgid % 8, off = wgid / 8; wgid = (xcd < r ? xcd * (q + 1) : r * (q + 1) + (xcd - r) * q) + off; }
        const int nig = 8 * nN, gid = wgid / nig, fm = gid * 8, gsz = (nM - fm) < 8 ? (nM - fm) : 8;
        u.pm = fm + ((wgid % nig) % gsz); u.pn = (wgid % nig) / gsz; u.z = 0; u.nrows = 256; u.aux = 0;
        u.A = A0 + (size_t)u.pm * 256 * lda_b + (size_t)u.pn * a_pn_b; u.B = B0 + (size_t)u.pn * b_pn_b; return true; }
    __device__ __forceinline__ unsigned row_off(const Unit&, int r) const { return (unsigned)r * lda_b; }
};
struct MoeSched {
    static constexpr bool GATHER = true;
    const int* cnt; const int* list; const char* A0; const char* B0; size_t b_e_b, b_pn_b; unsigned lda_b; int npn, G, c; const LAS int* tab;
    __device__ __forceinline__ void build(LAS int* tabw) {
        if (threadIdx.x < 32) { const int i = threadIdx.x; long L = (long)i * G + c; int tb = 0, fe = -1, fpm = 0, fpl = 0, fpn = 0;
            for (int e = 0; e < NE; ++e) { const int nt = (cnt[e] + 255) >> 8; const long nu = (long)nt * npn;
                if (fe < 0 && L < nu) { fe = e; fpl = (int)(L / npn); fpn = (int)(L % npn); fpm = tb + fpl; }
                L -= nu; tb += nt; }
            int nr = 0; if (fe >= 0) { nr = cnt[fe] - fpl * 256; nr = nr < 256 ? nr : 256; }
            tabw[4 * i + 0] = fe; tabw[4 * i + 1] = fpm; tabw[4 * i + 2] = fpl | (nr << 16); tabw[4 * i + 3] = fpn; }
        tab = tabw; __syncthreads(); }
    __device__ __forceinline__ bool next(int i, Unit& u) const {
        if (i >= 32) return false;
        const v4i ent = *(const LAS v4i*)(tab + 4 * i);
        const int e = __builtin_amdgcn_readfirstlane(ent[0]); if (e < 0) return false;
        u.z = e; u.pm = __builtin_amdgcn_readfirstlane(ent[1]); const int an = __builtin_amdgcn_readfirstlane(ent[2]); u.aux = an & 0xffff; u.nrows = an >> 16; u.pn = __builtin_amdgcn_readfirstlane(ent[3]);
        u.A = A0;       u.B = B0 + (size_t)e * b_e_b + (size_t)u.pn * b_pn_b; return true; }
    __device__ __forceinline__ int row_idx(const Unit& u, int r) const { const int rr = r < u.nrows ? r : u.nrows - 1; return list[(size_t)u.z * T_ + u.aux * 256 + rr]; }
    __device__ __forceinline__ unsigned idx_off(int idx) const { return (unsigned)idx * lda_b; }
    __device__ __forceinline__ unsigned row_off(const Unit& u, int r) const { return idx_off(row_idx(u, r)); }
};
struct MoeSchedC : MoeSched {
    static constexpr bool GATHER = false;
    __device__ __forceinline__ bool next(int i, Unit& u) const { if (!MoeSched::next(i, u)) return false; u.A = A0 + (size_t)u.pm * 256 * lda_b; return true; }
    __device__ __forceinline__ unsigned row_off(const Unit&, int r) const { return (unsigned)r * lda_b; }
};

#define EPI_ROWS_BEGIN _Pragma("unroll") for (int ai = 0; ai < 2; ++ai) _Pragma("unroll") for (int m = 0; m < 4; ++m) { const int r = ai * 128 + wr * 64 + m * 16 + fr; const int j0 = wc * 32 + fq * 8; (void)j0;
#define EPI_ROWS_END asm volatile("" ::: "memory"); }
__device__ __forceinline__ u32x4 pack8(const f32x4& a, const f32x4& b) { u32x4 w; w.x = cvt_pk_bf16(a[0], a[1]); w.y = cvt_pk_bf16(a[2], a[3]); w.z = cvt_pk_bf16(b[0], b[1]); w.w = cvt_pk_bf16(b[2], b[3]); return w; }
struct EpiMoeUp {
    static constexpr bool HAS_PRE = true;
    const float* b1; unsigned char* ACT;
    __device__ __forceinline__ float pre(const Unit& u, int tid) const { return tid < 256 ? b1[(size_t)u.z * 2 * DFF + (tid >> 7) * DFF + u.pn * 128 + (tid & 127)] : 0.f; }
    __device__ __forceinline__ void operator()(const Acc& acc, const Unit& u, int wr, int wc, int fr, int fq, const LAS float* bb) const {
        const LAS float* bg = bb + wc * 32 + fq * 8;
        const f32x4 g0b = *(const LAS f32x4*)bg, g1b = *(const LAS f32x4*)(bg + 4), u0b = *(const LAS f32x4*)(bg + 128), u1b = *(const LAS f32x4*)(bg + 132);
#pragma unroll
        for (int ai = 0; ai < 2; ++ai)
#pragma unroll
          for (int mp = 0; mp < 2; ++mp) { u32x2 wv[2];
#pragma unroll
            for (int mm = 0; mm < 2; ++mm) { const int m = 2 * mp + mm;
            f32x4 o[2];
#pragma unroll
            for (int n = 0; n < 2; ++n) { const f32x4 gv = acc[ai][0][m][n] * (1.0f / W1_SCALE) + (n ? g1b : g0b), uv = acc[ai][1][m][n] * (1.0f / W1_SCALE) + (n ? u1b : u0b);
                f32x4 gc, uc, sg;
#pragma unroll
                for (int e = 0; e < 4; ++e) { gc[e] = fminf(gv[e], SW_LIMIT); uc[e] = fminf(fmaxf(uv[e], -SW_LIMIT), SW_LIMIT); sg[e] = __builtin_amdgcn_rcpf(1.0f + __builtin_amdgcn_exp2f((-SW_ALPHA * 1.4426950408889634f) * gc[e])); }
                o[n] = (uc * ACT_SCALE + ACT_SCALE) * (gc * sg); }
            wv[mm].x = pk4_fp8(o[0][0], o[0][1], o[0][2], o[0][3]); wv[mm].y = pk4_fp8(o[1][0], o[1][1], o[1][2], o[1][3]); }
            const auto rx = __builtin_amdgcn_permlane16_swap(wv[0].x, wv[1].x, false, false), ry = __builtin_amdgcn_permlane16_swap(wv[0].y, wv[1].y, false, false);
            const int r = ai * 128 + wr * 64 + (2 * mp + (fq & 1)) * 16 + fr, j0 = wc * 32 + (fq & ~1) * 8;
            *(u32x4*)(ACT + ((size_t)u.pm * 256 + r) * DFF + u.pn * 128 + j0) = (u32x4){rx[0], ry[0], rx[1], ry[1]};
            asm volatile("" ::: "memory"); }
    }
};
struct EpiMoeDown {
    static constexpr bool HAS_PRE = true;
    const float* b2; unsigned char* YC;
    __device__ __forceinline__ float pre(const Unit& u, int tid) const { return tid < 256 ? b2[(size_t)u.z * D_ + u.pn * 256 + tid] : 0.f; }
    __device__ __forceinline__ void operator()(const Acc& acc, const Unit& u, int wr, int wc, int fr, int fq, const LAS float* bb) const {
        const LAS float* bp = bb + wc * 32 + fq * 8; constexpr float ds = YC_SCALE / (ACT_SCALE * W2_SCALE);
        f32x4 bv[2][2];
#pragma unroll
        for (int bj = 0; bj < 2; ++bj)
#pragma unroll
            for (int n = 0; n < 2; ++n) bv[bj][n] = *(const LAS f32x4*)(bp + bj * 128 + 4 * n) * YC_SCALE;
#pragma unroll
        for (int ai = 0; ai < 2; ++ai)
#pragma unroll
          for (int mp = 0; mp < 2; ++mp) {
            const int r = ai * 128 + wr * 64 + (2 * mp + (fq & 1)) * 16 + fr, j0 = wc * 32 + (fq & ~1) * 8;
#pragma unroll
            for (int bj = 0; bj < 2; ++bj) { u32x2 wv[2];
#pragma unroll
                for (int mm = 0; mm < 2; ++mm) { const int m = 2 * mp + mm; f32x4 o0 = acc[ai][bj][m][0] * ds + bv[bj][0], o1 = acc[ai][bj][m][1] * ds + bv[bj][1];
#pragma unroll
                    for (int e = 0; e < 4; ++e) { o0[e] = __builtin_amdgcn_fmed3f(o0[e], -448.0f, 448.0f); o1[e] = __builtin_amdgcn_fmed3f(o1[e], -448.0f, 448.0f); }
                    wv[mm].x = pk4_fp8(o0[0], o0[1], o0[2], o0[3]); wv[mm].y = pk4_fp8(o1[0], o1[1], o1[2], o1[3]); }
                const auto rx = __builtin_amdgcn_permlane16_swap(wv[0].x, wv[1].x, false, false), ry = __builtin_amdgcn_permlane16_swap(wv[0].y, wv[1].y, false, false);
                *(u32x4*)(YC + ((size_t)u.pm * 256 + r) * D_ + u.pn * 256 + bj * 128 + j0) = (u32x4){rx[0], ry[0], rx[1], ry[1]}; }
            asm volatile("" ::: "memory"); }
    }
};
struct CmpSched {             static constexpr bool GATHER = false;
    const char* KV; const char* W; int G, c;
    __device__ __forceinline__ bool next(int i, Unit& u) const { const int L = i * G + c; if (L >= 2 * NBG) return false; const int tz = L / NBG, bg = L % NBG, b = bg / NG, g = bg % NG;
        u.z = L; u.pm = 0; u.pn = 0; u.nrows = NCMP; u.aux = 0; u.A = KV + ((size_t)b * S_ * NKVW + tz * 128 + g * 64) * 2; u.B = W + (size_t)tz * 256 * 2048 * 2; return true; }
    __device__ __forceinline__ unsigned row_off(const Unit&, int r) const { return (unsigned)r * (16u * NKVW * 2u); }
};
struct EpiPlain {
    static constexpr bool HAS_PRE = false;
    bf16* O; int ldo; const float* bias;
    __device__ __forceinline__ void operator()(const Acc& acc, const Unit& u, int wr, int wc, int fr, int fq) const {
        f32x4 bv[2][2];
#pragma unroll
        for (int bj = 0; bj < 2; ++bj)
#pragma unroll
            for (int n = 0; n < 2; ++n) bv[bj][n] = bias ? *(const f32x4*)(bias + u.pn * 256 + bj * 128 + wc * 32 + fq * 8 + 4 * n) : (f32x4){0.f, 0.f, 0.f, 0.f};
        EPI_ROWS_BEGIN
#pragma unroll
            for (int bj = 0; bj < 2; ++bj) *(u32x4*)(O + (size_t)(u.pm * 256 + r) * ldo + u.pn * 256 + bj * 128 + j0) = pack8(acc[ai][bj][m][0] + bv[bj][0], acc[ai][bj][m][1] + bv[bj][1]);
        EPI_ROWS_END
    }
};
struct EpiPool {
    static constexpr bool HAS_PRE = false;
    bf16* O; const float* pb; const float* ps;
    __device__ __forceinline__ void operator()(const Acc& acc, const Unit& u, int wr, int wc, int fr, int fq) const {
        f32x4 bv[2][2], sv[2][2];
#pragma unroll
        for (int bj = 0; bj < 2; ++bj)
#pragma unroll
            for (int n = 0; n < 2; ++n) { const int c = u.pn * 256 + bj * 128 + wc * 32 + fq * 8 + 4 * n; bv[bj][n] = *(const f32x4*)(pb + c); sv[bj][n] = *(const f32x4*)(ps + c); }
        EPI_ROWS_BEGIN
#pragma unroll
            for (int bj = 0; bj < 2; ++bj) *(u32x4*)(O + (size_t)(u.pm * 256 + r) * D_ + u.pn * 256 + bj * 128 + j0) = pack8((acc[ai][bj][m][0] + bv[bj][0]) * sv[bj][0], (acc[ai][bj][m][1] + bv[bj][1]) * sv[bj][1]);
        EPI_ROWS_END
    }
};
struct EpiGlu {
    static constexpr bool HAS_PRE = false;
    bf16* U; const float* bias;
    __device__ __forceinline__ void operator()(const Acc& acc, const Unit& u, int wr, int wc, int fr, int fq) const {
        const float* ba = bias + u.pn * 128 + wc * 32 + fq * 8; const float* bg = ba + D_;
        const f32x4 a0 = *(const f32x4*)ba, a1 = *(const f32x4*)(ba + 4), g0 = *(const f32x4*)bg, g1 = *(const f32x4*)(bg + 4);
        EPI_ROWS_BEGIN
            f32x4 o[2];
#pragma unroll
            for (int n = 0; n < 2; ++n) { const f32x4 av = acc[ai][0][m][n] + (n ? a1 : a0), gv = acc[ai][1][m][n] + (n ? g1 : g0);
#pragma unroll
                for (int e = 0; e < 4; ++e) o[n][e] = av[e] * fast_sigmoid(gv[e]); }
            *(u32x4*)(U + (size_t)(u.pm * 256 + r) * D_ + u.pn * 128 + j0) = pack8(o[0], o[1]);
        EPI_ROWS_END
    }
};
__device__ __forceinline__ void rope_store8(const f32x4& x10, const f32x4& x11, const f32x4& x20, const f32x4& x21, const float* cs, const float* sn, float sc, bf16* p1, bf16* p2) {
    const f32x4 c0 = *(const f32x4*)cs, c1 = *(const f32x4*)(cs + 4), s0 = *(const f32x4*)sn, s1 = *(const f32x4*)(sn + 4);
    *(u32x4*)p1 = pack8((x10 * c0 - x20 * s0) * sc, (x11 * c1 - x21 * s1) * sc);
    *(u32x4*)p2 = pack8((x10 * s0 + x20 * c0) * sc, (x11 * s1 + x21 * c1) * sc);
}
struct EpiRetIn {
    static constexpr bool HAS_PRE = false;
    bf16* O; const float* cs; const float* sn;
    __device__ __forceinline__ void operator()(const Acc& acc, const Unit& u, int wr, int wc, int fr, int fq) const {
        const float sc = u.pn >= 4 ? 0.0625f : 1.0f;
        EPI_ROWS_BEGIN
            const size_t t = (size_t)u.pm * 256 + r; bf16* p = O + t * RW + u.pn * 256 + j0;
            if (u.pn < 8) rope_store8(acc[ai][0][m][0], acc[ai][0][m][1], acc[ai][1][m][0], acc[ai][1][m][1], cs + t * 128 + j0, sn + t * 128 + j0, sc, p, p + 128);
            else { *(u32x4*)p = pack8(acc[ai][0][m][0], acc[ai][0][m][1]); *(u32x4*)(p + 128) = pack8(acc[ai][1][m][0], acc[ai][1][m][1]); }
        EPI_ROWS_END
    }
};
struct EpiNsaIn {
    static constexpr bool HAS_PRE = false;
    bf16* Q; bf16* KV; float* GT; const float* gate_b; const float* cs; const float* sn;
    __device__ __forceinline__ void operator()(const Acc& acc, const Unit& u, int wr, int wc, int fr, int fq) const {
        const int i0 = fq * 8;
        EPI_ROWS_BEGIN
            const size_t t = (size_t)u.pm * 256 + r; const f32x4& x10 = acc[ai][0][m][0]; const f32x4& x11 = acc[ai][0][m][1]; const f32x4& x20 = acc[ai][1][m][0]; const f32x4& x21 = acc[ai][1][m][1];
            if (u.pn < 4) { bf16* p = Q + t * D_ + (4 * u.pn + wc) * 64 + i0; rope_store8(x10, x11, x20, x21, cs + t * 32 + i0, sn + t * 32 + i0, 0.125f * 1.4426950408889634f, p, p + 32); }
            else if (u.pn == 4) { bf16* p = KV + t * NKVW + (wc < 2 ? 0 : 256) + (wc & 1) * 64 + i0; rope_store8(x10, x11, x20, x21, cs + t * 32 + i0, sn + t * 32 + i0, 1.0f, p, p + 32); }
            else if (u.pn == 5) {
                if (wc < 2) { bf16* p = KV + t * NKVW + 512 + wc * 64 + i0; rope_store8(x10, x11, x20, x21, cs + t * 32 + i0, sn + t * 32 + i0, 1.0f, p, p + 32); }
                else { bf16* p = KV + t * NKVW + 128 + (j0 - 64); *(u32x4*)p = pack8(x10, x11); *(u32x4*)(p + 64) = pack8(x20, x21); } }
            else if (u.pn == 6) { bf16* p = KV + t * NKVW + 384 + j0; *(u32x4*)p = pack8(x10, x11); *(u32x4*)(p + 256) = pack8(x20, x21); }
            else if (j0 < 48) { float* p = GT + t * 48 + j0; const f32x4 b0 = *(const f32x4*)(gate_b + j0), b1 = *(const f32x4*)(gate_b + j0 + 4); f32x4 o0, o1;
#pragma unroll
                for (int e = 0; e < 4; ++e) { o0[e] = fast_sigmoid(x10[e] + b0[e]); o1[e] = fast_sigmoid(x11[e] + b1[e]); }
                *(f32x4*)p = o0; *(f32x4*)(p + 4) = o1; }
        EPI_ROWS_END
    }
};
struct EpiCmp1 {
    static constexpr bool HAS_PRE = false;
    bf16* H; const float* cb;
    __device__ __forceinline__ void operator()(const Acc& acc, const Unit& u, int wr, int wc, int fr, int fq) const {
        const float* b = cb + (u.z / NBG) * 256 + wc * 32 + fq * 8;
        EPI_ROWS_BEGIN
            if (r < NCMP) {
#pragma unroll
                for (int bj = 0; bj < 2; ++bj) { f32x4 o[2];
#pragma unroll
                    for (int n = 0; n < 2; ++n) { const f32x4 bv = *(const f32x4*)(b + bj * 128 + 4 * n);
#pragma unroll
                        for (int e = 0; e < 4; ++e) o[n][e] = gelu_tanh(acc[ai][bj][m][n][e] + bv[e]); }
                    *(u32x4*)(H + ((size_t)u.z * 256 + r) * 256 + bj * 128 + j0) = pack8(o[0], o[1]); } }
        EPI_ROWS_END
    }
};
struct EpiRopeT {
    static constexpr bool HAS_PRE = false;
    bf16* KT; const float* csT; const float* snT;
    __device__ __forceinline__ void operator()(const Acc& acc, const Unit& u, int wr, int wc, int fr, int fq) const {
#pragma unroll
        for (int m = 0; m < 4; ++m) { const int i = wr * 64 + m * 16 + fr;
#pragma unroll
            for (int bj = 0; bj < 2; ++bj) { const size_t t0 = (size_t)u.pn * 256 + bj * 128 + wc * 32 + fq * 8;
                const f32x4 c0 = *(const f32x4*)(csT + (size_t)i * T_ + t0), c1 = *(const f32x4*)(csT + (size_t)i * T_ + t0 + 4), s0 = *(const f32x4*)(snT + (size_t)i * T_ + t0), s1 = *(const f32x4*)(snT + (size_t)i * T_ + t0 + 4);
                const f32x4& x10 = acc[0][bj][m][0]; const f32x4& x11 = acc[0][bj][m][1]; const f32x4& x20 = acc[1][bj][m][0]; const f32x4& x21 = acc[1][bj][m][1];
                *(u32x4*)(KT + ((size_t)u.pm * 256 + i) * T_ + t0) = pack8((x10 * c0 - x20 * s0) * 0.0625f, (x11 * c1 - x21 * s1) * 0.0625f);
                *(u32x4*)(KT + ((size_t)u.pm * 256 + 128 + i) * T_ + t0) = pack8((x10 * s0 + x20 * c0) * 0.0625f, (x11 * s1 + x21 * c1) * 0.0625f); }
            asm volatile("" ::: "memory"); }
    }
};
}
#endif

constexpr int PH_PER_LAYER = 24, PH_TOTAL = 1 + DEPTH * PH_PER_LAYER;

#ifdef HOSTTEST
#define PH(id, ...) do { if (ph_lo <= (id) && (id) < ph_hi) { __VA_ARGS__; } } while (0)
#define LAYER_ARGS const Ctx& C, int ph_lo, int ph_hi
#define LAYER_PASS C, ph_lo, ph_hi
#define LAYER_FN template <int l> static void
#else
__device__ __forceinline__ constexpr bool probe_dup(int id) {
    if (PROBE_KIND == 0) return false;
    if (id == 0) return PROBE_KIND == 1;
    const int l = (id - 1) / 24, k = (id - 1) % 24;
    if (PROBE_KIND == 2) return k == 17 || k == 19;
    if (PROBE_KIND == 3) return l == 2 && k == 6;
    if (PROBE_KIND == 4) return l == 0 && k == 4;
    if (PROBE_KIND == 5) return (l == 0 && (k == 1 || k == 6)) || (l == 1 && (k == 0 || k == 4)) || (l == 2 && (k == 0 || k == 7));
    if (PROBE_KIND == 7) return (l == 0 && (k == 0 || k == 5)) || (l == 1 && k == 2) || (l == 2 && (k == 2 || k == 3)) || (l == 3 && (k == 0 || k == 1));
    return false;
}
#define PH(id, ...) do { if (ph_lo <= (id) && (id) < ph_hi) { __VA_ARGS__; if (probe_dup(id)) { if (multi) xcd_barrier(bar); __VA_ARGS__; } if (multi) xcd_barrier(bar); if (PROBE_KIND == 8) { xcd_barrier(bar); xcd_barrier(bar); } } } while (0)
typedef Ctx Args;
#define LAYER_ARGS const Ctx& C, int ph_lo, int ph_hi, bool multi, const XcdBarrier& bar, LAS unsigned char* lds
#define LAYER_PASS C, ph_lo, ph_hi, multi, bar, lds
#define LAYER_FN template <int l> __device__ __forceinline__ void
#endif
LAYER_FN layer_program(LAYER_ARGS) {

        const int pb = 1 + l * PH_PER_LAYER;
        if constexpr (l == 0) {
#ifdef HOSTTEST
            PH(pb + 0, PHASE(ph_modx0(C, gt, gs)));
#else
            PH(pb + 0, modx0_fast(C));
#endif
#ifdef HOSTTEST
            PH(pb + 1, { G_Dense g = mk_dense(C.w<bf16>(WS_H), D_, C.f(I_RET_W_IN), D_, RW, nullptr, C.w<bf16>(WS_QKVG), RW); GEMM(g); });
            PH(pb + 2, PHASE(ph_ret_rope(C, gt, gs)));
#else
            PH(pb + 1, { { pg8::DenseSched S; S.init(C.w<bf16>(WS_H), D_ * 2, C.w<bf16>(WS_RWIN), (size_t)256 * D_ * 2, T_, 2048); pg8::EpiRetIn E{C.w<bf16>(WS_QKVG), C.w<float>(WS_COS256), C.w<float>(WS_SIN256)};
                           pg8::GemmP P{D_, D_ * 2, 128}; pg8::gemm8<pg8::EpiRetIn, pg8::DenseSched, true>(lds, P, S, E); }
                         { pg8::DenseSched S; S.init(C.w<bf16>(WS_H), D_ * 2, C.w<bf16>(WS_RWIN) + (size_t)4096 * D_, (size_t)256 * D_ * 2, T_, 2048); pg8::EpiPlain E{C.w<bf16>(WS_QKVG) + 4096, RW, nullptr};
                           pg8::GemmP P{D_, D_ * 2, 128}; pg8::gemm8<pg8::EpiPlain, pg8::DenseSched, true>(lds, P, S, E); }
                         { pg8::DenseSched S; S.init(C.w<bf16>(WS_RWIN) + (size_t)2048 * D_, D_ * 2, C.w<bf16>(WS_H), (size_t)256 * D_ * 2, 2048, T_); pg8::EpiPlain E{C.w<bf16>(WS_VT), T_, nullptr};
                           pg8::GemmP P{D_, D_ * 2, 128}; pg8::gemm8<pg8::EpiPlain, pg8::DenseSched, true>(lds, P, S, E); } });
#endif
#ifdef HOSTTEST
            PH(pb + 3, PHASE(ph_ret_p(C, gt, gs)); PHASE(ph_ret_state(C, gt, gs)));
            PH(pb + 4, PHASE(ph_ret_o(C, gt, gs)));
#else
            PH(pb + 4, ret_core_fast(C, lds));
#endif
#ifdef HOSTTEST
            PH(pb + 5, PHASE(ph_ret_gn(C, gt, gs)));
#else
            PH(pb + 5, ret_gn_fast(C));
#endif
#ifdef HOSTTEST
            PH(pb + 6, { G_Dense g = mk_dense(C.w<bf16>(WS_RA2), RH * RDV, C.f(I_RET_W_OUT), RH * RDV, D_, nullptr, C.w<bf16>(WS_Y), D_); GEMM(g); });
#else
            PH(pb + 6, { pg8::DenseSched S; S.init(C.w<bf16>(WS_RA2), 2048 * 2, C.w<bf16>(WS_RWOUT), (size_t)256 * 2048 * 2, T_, D_); pg8::EpiPlain E{C.w<bf16>(WS_Y), D_, nullptr}; pg8::GemmP P{2048, 2048 * 2, 128}; pg8::gemm8<pg8::EpiPlain, pg8::DenseSched, true>(lds, P, S, E); });
#endif
        } else if constexpr (l == 1) {
#ifdef HOSTTEST
            PH(pb + 0, { G_Dense g = mk_dense(C.w<bf16>(WS_H), D_, C.f(I_CONV_W_PW1), D_, 2 * D_, C.f(I_CONV_B_PW1), C.w<bf16>(WS_CRAW), 2 * D_); GEMM(g); });
            PH(pb + 1, PHASE(ph_conv_glu(C, gt, gs)));
#else
            PH(pb + 0, { pg8::DenseSched S; S.init(C.w<bf16>(WS_H), D_ * 2, C.w<bf16>(WS_CPW1), (size_t)256 * D_ * 2, T_, 2 * D_); pg8::EpiGlu E{C.w<bf16>(WS_CU), C.f(I_CONV_B_PW1)}; pg8::GemmP P{D_, D_ * 2, 128}; pg8::gemm8<pg8::EpiGlu, pg8::DenseSched, true>(lds, P, S, E); });
#endif
#ifdef HOSTTEST
            PH(pb + 2, PHASE(ph_conv_dw(C, gt, gs)));
            PH(pb + 3, PHASE(ph_conv_ln(C, gt, gs)));
#else
            PH(pb + 2, conv_fast(C, lds));
#endif
#ifdef HOSTTEST
            PH(pb + 4, { G_Dense g = mk_dense(C.w<bf16>(WS_CA2), D_, C.f(I_CONV_W_PW2), D_, D_, C.f(I_CONV_B_PW2), C.w<bf16>(WS_Y), D_); GEMM(g); });
#else
            PH(pb + 4, { pg8::DenseSched S; S.init(C.w<bf16>(WS_CA2), D_ * 2, C.w<bf16>(WS_CPW2), (size_t)256 * D_ * 2, T_, D_); pg8::EpiPlain E{C.w<bf16>(WS_Y), D_, C.f(I_CONV_B_PW2)}; pg8::GemmP P{D_, D_ * 2, 128}; pg8::gemm8<pg8::EpiPlain, pg8::DenseSched, true>(lds, P, S, E); });
#endif
        } else if constexpr (l == 2) {
#ifdef HOSTTEST
            PH(pb + 0, { G_NsaIn g; g.Z = 1; g.MT = T_ / 128; g.N = NINW; g.K = D_; g.A = C.w<bf16>(WS_H); g.W = C.f(I_NSA_W_IN); g.Q = C.w<bf16>(WS_NQ); g.KV = C.w<bf16>(WS_NKV);
                         g.GT = C.w<float>(WS_NGT); g.gate_b = C.f(I_NSA_GATE_B); GEMM(g); });
            PH(pb + 1, PHASE(ph_nsa_rope(C, gt, gs)));
            PH(pb + 2, { G_Cmp1 g; g.Z = 2 * NBG; g.MT = 2; g.N = 256; g.K = 2048; g.KV = C.w<bf16>(WS_NKV); g.w1k = C.f(I_NSA_K_W1); g.w1v = C.f(I_NSA_V_W1); g.cb = C.w<float>(WS_CB);
                         g.H = C.w<bf16>(WS_CMPH); GEMM(g); });
#else
            PH(pb + 0, { pg8::DenseSched S; S.init(C.w<bf16>(WS_H), D_ * 2, C.w<bf16>(WS_NWIN), (size_t)256 * D_ * 2, T_, 2048); pg8::EpiNsaIn E{C.w<bf16>(WS_NQ), C.w<bf16>(WS_NKV), C.w<float>(WS_NGT), C.f(I_NSA_GATE_B), C.w<float>(WS_COS64), C.w<float>(WS_SIN64)}; pg8::GemmP P{D_, D_ * 2, 128}; pg8::gemm8<pg8::EpiNsaIn, pg8::DenseSched, true>(lds, P, S, E); });
            PH(pb + 2, { pg8::CmpSched S; S.KV = (const char*)C.w<bf16>(WS_NKV); S.W = (const char*)C.w<bf16>(WS_CW1T); S.G = gridDim.x; S.c = blockIdx.x; pg8::EpiCmp1 E{C.w<bf16>(WS_CMPH), C.w<float>(WS_CB)};
                         pg8::GemmP P{2048, 2048 * 2, NKVW * 2}; pg8::gemm8<pg8::EpiCmp1, pg8::CmpSched, true>(lds, P, S, E); });
#endif
            PH(pb + 3, { G_Cmp2 g; g.Z = 2 * NBG; g.MT = 2; g.N = 64; g.K = 256; g.H = C.w<bf16>(WS_CMPH); g.w2k = C.f(I_NSA_K_W2); g.w2v = C.f(I_NSA_V_W2); g.O = C.w<bf16>(WS_CMPKV); GEMM(g); });
#ifdef HOSTTEST
            PH(pb + 4, PHASE(ph_nsa_cmp_attn(C, gt, gs)));
            PH(pb + 5, PHASE(ph_nsa_select(C, gt, gs)));
            PH(pb + 6, PHASE(ph_nsa_attn(C, gt, gs)));
#else
            PH(pb + 6, nsa_attn_fast(C, lds));
#endif
#ifdef HOSTTEST
            PH(pb + 7, { G_Dense g = mk_dense(C.w<bf16>(WS_NO), D_, C.f(I_NSA_W_OUT), D_, D_, nullptr, C.w<bf16>(WS_Y), D_); GEMM(g); });
#else
            PH(pb + 7, { pg8::DenseSched S; S.init(C.w<bf16>(WS_NO), D_ * 2, C.w<bf16>(WS_NWOUT), (size_t)256 * D_ * 2, T_, D_); pg8::EpiPlain E{C.w<bf16>(WS_Y), D_, nullptr}; pg8::GemmP P{D_, D_ * 2, 128}; pg8::gemm8<pg8::EpiPlain, pg8::DenseSched, true>(lds, P, S, E); });
#endif
        } else {
#ifdef HOSTTEST
            PH(pb + 0, PHASE(ph_pool(C, gt, gs)));
#else
            PH(pb + 0, pool_fast(C, lds));
#endif
#ifdef HOSTTEST
            PH(pb + 1, { G_Pool g; g.Z = 4; g.MT = T_ / 128; g.N = 256; g.K = 256; g.PL = C.w<bf16>(WS_PL); g.W = C.f(I_POOL_W); g.pb = C.f(I_POOL_B); g.ps = C.f(I_POOL_SCALE);
                         g.Y = C.w<bf16>(WS_Y); GEMM(g); });
#else
            PH(pb + 1, { pg8::DenseSched S; S.init(C.w<bf16>(WS_PL), D_ * 2, C.w<bf16>(WS_PWT), (size_t)256 * 256 * 2, T_, D_, 512); pg8::EpiPool E{C.w<bf16>(WS_Y), C.f(I_POOL_B), C.f(I_POOL_SCALE)}; pg8::GemmP P{256, 256 * 2, 128}; pg8::gemm8<pg8::EpiPool, pg8::DenseSched, true>(lds, P, S, E); });
#endif
        }
#ifdef HOSTTEST
        PH(pb + 16, PHASE(ph_ln(C, l, 0, gt, gs)));
#else
        PH(pb + 16, ln_fast<0, false, l == 0, false>(C, l, lds));
#endif
#ifdef HOSTTEST
        PH(pb + 17, { G_MoeUp g; g.Z = NE; g.MT = T_ / 128; g.N = 2 * DFF; g.K = D_; g.Hh = C.w<bf16>(WS_H); g.list = C.w<int>(WS_LIST); g.cnt = C.cnt(l);
                      g.W = C.f(I_MOE_W1) + (size_t)l * NE * D_ * 2 * DFF; g.b1 = C.f(I_MOE_B1) + (size_t)l * NE * 2 * DFF; g.GU = C.w<bf16>(WS_GU); GEMM(g); });
        PH(pb + 18, PHASE(ph_moe_act(C, gt, gs)));
        PH(pb + 19, { G_MoeDown g; g.Z = NE; g.MT = T_ / 128; g.N = D_; g.K = DFF; g.ACT = C.w<bf16>(WS_ACT); g.list = C.w<int>(WS_LIST); g.cnt = C.cnt(l);
                      g.W = C.f(I_MOE_W2) + (size_t)l * NE * DFF * D_; g.b2 = C.f(I_MOE_B2) + (size_t)l * NE * D_; g.YS = C.w<bf16>(WS_YS); GEMM(g); });
#else
        PH(pb + 17, { pg8::MoeSched S; S.cnt = C.cnt(l); S.list = C.w<int>(WS_LIST); S.A0 = (const char*)C.w<unsigned char>(WS_H8); S.B0 = (const char*)C.w<unsigned char>(WS_W1T) + (size_t)l * NE * 2 * DFF * D_;
                      S.b_e_b = (size_t)2 * DFF * D_; S.b_pn_b = (size_t)256 * D_; S.lda_b = D_; S.npn = 8; S.G = gridDim.x; S.c = (blockIdx.x % 8) * (gridDim.x / 8) + blockIdx.x / 8; S.build((LAS int*)(lds + 132096));
                      pg8::EpiMoeUp E{C.f(I_MOE_B1) + (size_t)l * NE * 2 * DFF, C.w<unsigned char>(WS_ACTC)}; pg8::GemmP P{PROBE_KIND == 10 ? D_ : D_ / 2, D_, 128, PROBE_KIND == 10 ? 8 : 0};
                      pg8::gemm8<pg8::EpiMoeUp, pg8::MoeSched, true, true>(lds, P, S, E); });
        PH(pb + 19, { pg8::MoeSchedC S; S.cnt = C.cnt(l); S.list = C.w<int>(WS_LIST); S.A0 = (const char*)C.w<unsigned char>(WS_ACTC); S.B0 = (const char*)C.w<unsigned char>(WS_W2T) + (size_t)l * NE * D_ * DFF;
                      S.b_e_b = (size_t)D_ * DFF; S.b_pn_b = (size_t)256 * DFF; S.lda_b = DFF; S.npn = 4; S.G = gridDim.x; S.c = (blockIdx.x % 8) * (gridDim.x / 8) + blockIdx.x / 8; S.build((LAS int*)(lds + 132096));
                      pg8::EpiMoeDown E{C.f(I_MOE_B2) + (size_t)l * NE * D_, C.w<unsigned char>(WS_YC)}; pg8::GemmP P{PROBE_KIND == 10 ? DFF : DFF / 2, DFF, 128, PROBE_KIND == 10 ? 8 : 0};
                      pg8::gemm8<pg8::EpiMoeDown, pg8::MoeSchedC, true, true>(lds, P, S, E); });
#endif
#ifdef HOSTTEST
        PH(pb + 20, PHASE(ph_ln(C, l, 1, gt, gs)));
#else
        PH(pb + 20, if (PROBE_KIND == 6) { ln_fast<1, true, false, false>(C, l, lds); xcd_barrier(bar); } ln_fast<1, false, false, l == DEPTH - 1>(C, l, lds));
#endif
}
#ifdef HOSTTEST
static void run_phases(const Ctx& C, int ph_lo, int ph_hi)
#else
__global__ void __launch_bounds__(NTHREADS, 2) fwd(const Args C)
#endif
{
#ifndef HOSTTEST
    extern __shared__ __attribute__((aligned(16))) unsigned char lds_raw[];
    LAS unsigned char* lds = (LAS unsigned char*)lds_raw;
    const int ph_lo = C.ph_lo, ph_hi = C.ph_hi; const bool multi = (ph_hi - ph_lo) > 1;
    volatile LAS unsigned* xbst = (volatile LAS unsigned*)(lds + LDS_MISC);
    if (threadIdx.x < 4) xbst[threadIdx.x] = 0u;
    __syncthreads();
    XcdBarrier bar; bar.bar = C.w<unsigned>(WS_CTL) + CW_BAR; bar.x = 0; bar.st = xbst;
    if (multi) bar = xcd_barrier_post(C.w<unsigned>(WS_CTL) + CW_BAR, xbst);
#endif
#ifdef HOSTTEST
    PH(0, PHASE(ph_prologue(C, gt, gs)));
#else
    PH(0, mod_fast(C, lds); cb_fast(C, lds); rope_tables(C); ph_convert_weights(C, lds));
#endif
    layer_program<0>(LAYER_PASS);
    layer_program<1>(LAYER_PASS);
    layer_program<2>(LAYER_PASS);
    layer_program<3>(LAYER_PASS);
}

#ifndef HOSTTEST
static bool phase_used(int id) {
    if (id == 0) return true;
    const int l = (id - 1) / PH_PER_LAYER, k = (id - 1) % PH_PER_LAYER;
    if (k >= 16) return k <= 20;
    const int nmix[4] = {7, 5, 8, 2};
    return k < nmix[l];
}
#ifndef ONE_LAUNCH
#define ONE_LAUNCH 1
#endif
extern "C" void kernel_launch(void* const* d_in, const int* in_sizes, int n_in, void* d_out, int out_size, void* d_ws, size_t ws_size, hipStream_t stream) {
    static int grid = 0;
    if (grid == 0) {
        if (n_in != N_IN || out_size != T_ * D_ || ws_size < WS_END) { fprintf(stderr, "kernel_launch: unexpected shapes (n_in %d out %d ws %zu need %zu)\n", n_in, out_size, ws_size, (size_t)WS_END); grid = -1; return; }
        int dev = 0, cus = 0;
        if (hipGetDevice(&dev) != hipSuccess || hipDeviceGetAttribute(&cus, hipDeviceAttributeMultiprocessorCount, dev) != hipSuccess) { grid = -1; return; }
        if (hipFuncSetAttribute((const void*)fwd, hipFuncAttributeMaxDynamicSharedMemorySize, LDS_BYTES) != hipSuccess) { grid = -1; return; }
        int per_cu = 0;
        if (hipOccupancyMaxActiveBlocksPerMultiprocessor(&per_cu, (const void*)fwd, NTHREADS, LDS_BYTES) != hipSuccess || per_cu < 1) { fprintf(stderr, "kernel_launch: occupancy query says %d\n", per_cu); }
        (void)hipGetLastError();
        if (cus < 256) { fprintf(stderr, "kernel_launch: built for 256 CUs (one resident workgroup each), found %d\n", cus); grid = -1; return; }
        grid = 256;
    }
    if (grid < 0) return;
    (void)in_sizes;
    (void)hipMemsetAsync((char*)d_ws + WS_CTL, 0, CTL_ZERO_BYTES, stream);
    Args a{};
    for (int i = 0; i < N_IN; ++i) a.in[i] = d_in[i];
    a.out = (float*)d_out; a.ws = (unsigned char*)d_ws;
#if ONE_LAUNCH
    a.ph_lo = 0; a.ph_hi = PH_TOTAL;
    hipLaunchKernelGGL(fwd, dim3(grid), dim3(NTHREADS), LDS_BYTES, stream, a);
#else
    for (int id = 0; id < PH_TOTAL; ++id) if (phase_used(id)) { a.ph_lo = id; a.ph_hi = id + 1; hipLaunchKernelGGL(fwd, dim3(grid), dim3(NTHREADS), LDS_BYTES, stream, a); }
#endif
}
#endif
```

```cpp
#ifndef HOSTTEST
#include <hip/hip_runtime.h>
#include <cstdio>
#define HD __host__ __device__ __forceinline__
#else
#include <cmath>
#include <cstring>
#include <cstdio>
#include <cstdlib>
#define HD inline
#endif
#include <cstdint>
#include <cstddef>

#ifndef PROBE_KIND
#define PROBE_KIND 0
#endif
#ifndef CFG_BATCH
#define CFG_BATCH 8
#endif
#ifndef CFG_SEQ
#define CFG_SEQ 4096
#endif
constexpr int NB = CFG_BATCH, S_ = CFG_SEQ, T_ = NB * S_, D_ = 1024, DEPTH = 4;
constexpr float DN_ALPHA = 1.6817928305074290f;
constexpr float LN_EPS = 1e-5f;
constexpr int RH = 4, RDK = 256, RDV = 512, RCH = 128, RNCH = S_ / RCH, RW = 2 * RH * RDK + 2 * RH * RDV;
constexpr int CW = 31;
constexpr int NH = 16, NG = 2, NDH = 64, NR = NH / NG, NCMP = (S_ - 32) / 16 + 1, NSEL = S_ / 64, KSEL = NSEL < 16 ? NSEL : 16, NWIN = 512;
constexpr int NKVW = 768, NINW = 1840, NBG = NB * NG;
constexpr int NE = 32, TOPK = 4, DFF = 1024;
constexpr float SW_LIMIT = 7.0f, SW_ALPHA = 1.702f;

typedef unsigned short bf16;
typedef unsigned long long u64;

HD unsigned f32_bits(float f) { unsigned u; __builtin_memcpy(&u, &f, 4); return u; }
HD float bits_f32(unsigned u) { float f; __builtin_memcpy(&f, &u, 4); return f; }
HD float bf2f(bf16 v) { return bits_f32((unsigned)v << 16); }
HD bf16 f2bf(float f) { unsigned u = f32_bits(f); return (bf16)((u + 0x7fffu + ((u >> 16) & 1u)) >> 16); }
HD float bfr(float f) { return bf2f(f2bf(f)); }
HD float sigmoidf_(float x) { return 1.0f / (1.0f + expf(-x)); }
HD float siluf_(float x) { return x * sigmoidf_(x); }
HD float gelu_tanh(float x) { return 0.5f * x * (1.0f + tanhf(0.7978845608028654f * (x + 0.044715f * x * x * x))); }
HD void sincos_acc(float x, float& s, float& c) {
    const double xd = (double)x; const double kq = rint(xd * 0.6366197723675814);
    const double y = xd - kq * 1.5707963267948966; const int q = (int)((long long)kq & 3);
    const float yf = (float)y, z = yf * yf;
    const float sp = yf + yf * z * (-1.6666654611e-1f + z * (8.3321608736e-3f + z * (-1.9515295891e-4f)));
    const float cp = 1.0f - 0.5f * z + z * z * (4.166664568298827e-2f + z * (-1.388731625493765e-3f + z * 2.443315711809948e-5f));
    if (q == 0) { s = sp; c = cp; } else if (q == 1) { s = cp; c = -sp; } else if (q == 2) { s = -sp; c = -cp; } else { s = -cp; c = sp; }
}

enum InIdx { I_X = 0, I_C, I_POS, I_ADA_W, I_ADA_B, I_LN1_G, I_LN1_B, I_LN2_G, I_LN2_B, I_ROUTER_W, I_ROUTER_B, I_MOE_W1, I_MOE_B1, I_MOE_W2, I_MOE_B2,
             I_RET_W_IN, I_RET_GN_G, I_RET_GN_B, I_RET_W_OUT, I_CONV_W_PW1, I_CONV_B_PW1, I_CONV_W_DW, I_CONV_B_DW, I_CONV_LN_G, I_CONV_LN_B, I_CONV_W_PW2, I_CONV_B_PW2,
             I_NSA_W_IN, I_NSA_GATE_B, I_NSA_POS_K, I_NSA_POS_V, I_NSA_K_W1, I_NSA_K_W2, I_NSA_V_W1, I_NSA_V_W2, I_NSA_W_OUT, I_POOL_W, I_POOL_B, I_POOL_SCALE, N_IN };

constexpr size_t al256(size_t x) { return (x + 255) & ~(size_t)255; }
constexpr size_t cmax(size_t a, size_t b) { return a > b ? a : b; }
constexpr size_t WS_CTL = 0, CTL_BYTES = 1u << 20, CTL_ZERO_BYTES = 32768;
constexpr size_t WS_MOD = WS_CTL + CTL_BYTES;
constexpr size_t WS_COS256 = al256(WS_MOD + (size_t)DEPTH * NB * 6 * D_ * 4);
constexpr size_t WS_SIN256 = al256(WS_COS256 + (size_t)T_ * 128 * 4);
constexpr size_t WS_COS64 = al256(WS_SIN256 + (size_t)T_ * 128 * 4);
constexpr size_t WS_SIN64 = al256(WS_COS64 + (size_t)T_ * 32 * 4);
constexpr size_t WS_CB = al256(WS_SIN64 + (size_t)T_ * 32 * 4);
constexpr size_t WS_H = al256(WS_CB + 2 * 256 * 4);
constexpr size_t WS_Y = al256(WS_H + (size_t)T_ * D_ * 2);
constexpr size_t WS_TOPW = al256(WS_Y + (size_t)T_ * D_ * 2);
constexpr size_t WS_LIST = al256(WS_TOPW + (size_t)T_ * 4 * 4);
constexpr size_t WS_MOE = al256(WS_LIST + (size_t)NE * T_ * 4);
constexpr size_t WS_ACT = WS_MOE;
constexpr size_t WS_YS = al256(WS_ACT + (size_t)T_ * 4 * DFF * 2);
constexpr size_t WS_GU = al256(WS_YS + (size_t)T_ * 4 * D_ * 2);
constexpr size_t MOE_ROWS = (size_t)T_ * 4 + NE * 256;
constexpr size_t WS_ACTC = WS_MOE;
constexpr size_t WS_YC = al256(WS_ACTC + MOE_ROWS * DFF * 2);
constexpr size_t WS_EP = al256(WS_YC + MOE_ROWS * D_ * 2);
constexpr size_t WS_H8 = al256(WS_EP + (size_t)T_ * 16);
static_assert(WS_H8 + (size_t)T_ * D_ <= WS_GU + (size_t)T_ * 4 * 2 * DFF * 2, "compact MoE buffers fit the naive region");
constexpr size_t WS_MX = al256(WS_GU + (size_t)T_ * 4 * 2 * DFF * 2);
constexpr size_t WS_QKVG = WS_MX;
constexpr size_t WS_RO = al256(WS_QKVG + (size_t)T_ * RW * 2);
constexpr size_t WS_RA2 = al256(WS_RO + (size_t)T_ * RH * RDV * 2);
constexpr size_t WS_RP = al256(WS_RA2 + (size_t)T_ * RH * RDV * 2);
constexpr size_t WS_RST = al256(WS_RP + (size_t)T_ * RH * RCH * 4);
constexpr size_t WS_KT = WS_RP;
constexpr size_t WS_VT = al256(WS_KT + (size_t)RH * RDK * T_ * 2);
constexpr size_t WS_RET_END = cmax(al256(WS_RST + (size_t)(RNCH - 1) * NB * RH * RDK * RDV * 4), al256(WS_VT + (size_t)RH * RDV * T_ * 2));
constexpr size_t WS_CRAW = WS_MX;
constexpr size_t WS_CU = al256(WS_CRAW + (size_t)T_ * 2 * D_ * 2);
constexpr size_t WS_CCV = al256(WS_CU + (size_t)T_ * D_ * 2);
constexpr size_t WS_CA2 = al256(WS_CCV + (size_t)T_ * D_ * 4);
constexpr size_t WS_CONV_END = al256(WS_CA2 + (size_t)T_ * D_ * 2);
constexpr size_t WS_NQ = WS_MX;
constexpr size_t WS_NKV = al256(WS_NQ + (size_t)T_ * D_ * 2);
constexpr size_t WS_NGT = al256(WS_NKV + (size_t)(T_ + 64) * NKVW * 2);
constexpr size_t WS_CMPH = al256(WS_NGT + (size_t)T_ * 48 * 4);
constexpr size_t WS_CMPKV = al256(WS_CMPH + (size_t)2 * NBG * 256 * 256 * 2);
constexpr size_t WS_SELM = al256(WS_CMPKV + (size_t)2 * NBG * 256 * 64 * 2);
constexpr size_t WS_NO = al256(WS_SELM + (size_t)T_ * 2 * 8);
constexpr size_t WS_OC = al256(WS_NO + (size_t)T_ * D_ * 2);
constexpr size_t WS_IMP = al256(WS_OC + (size_t)T_ * D_ * 4);
constexpr size_t WS_PC = al256(WS_IMP + (size_t)T_ * 2 * 64 * 4);
constexpr size_t WS_NSA_END = al256(WS_PC + (size_t)T_ * 16 * 256 * 4);
constexpr size_t WS_PL = WS_MX;
constexpr size_t WS_POOL_END = al256(WS_PL + (size_t)T_ * D_ * 2);
constexpr size_t WS_MIX_END = cmax(cmax(WS_RET_END, WS_CONV_END), cmax(WS_NSA_END, WS_POOL_END));
constexpr size_t WS_W1T = WS_MIX_END;
constexpr size_t WS_W2T = al256(WS_W1T + (size_t)DEPTH * NE * 2 * DFF * D_ * 2);
constexpr size_t WS_RWIN = al256(WS_W2T + (size_t)DEPTH * NE * D_ * DFF * 2);
constexpr size_t WS_RWOUT = al256(WS_RWIN + (size_t)RW * D_ * 2);
constexpr size_t WS_CPW1 = al256(WS_RWOUT + (size_t)D_ * 2048 * 2);
constexpr size_t WS_CPW2 = al256(WS_CPW1 + (size_t)2048 * D_ * 2);
constexpr size_t WS_NWIN = al256(WS_CPW2 + (size_t)D_ * D_ * 2);
constexpr size_t WS_NWOUT = al256(WS_NWIN + (size_t)2048 * D_ * 2);
constexpr size_t WS_CW1T = al256(WS_NWOUT + (size_t)D_ * D_ * 2);
constexpr size_t WS_PWT = al256(WS_CW1T + (size_t)2 * 256 * 2048 * 2);
constexpr size_t WS_COS256T = al256(WS_PWT + (size_t)4 * 256 * 256 * 2);
constexpr size_t WS_SIN256T = al256(WS_COS256T + (size_t)128 * T_ * 4);
constexpr size_t WS_XB = al256(WS_SIN256T + (size_t)128 * T_ * 4);
constexpr size_t WS_END = al256(WS_XB + (size_t)T_ * D_ * 2);

constexpr int CW_CNT = 64;
constexpr int CW_BAR = 4096;

struct Ctx {
    const void* in[N_IN];
    float* out;
    unsigned char* ws;
    int ph_lo, ph_hi;
    HD const float* f(int i) const { return (const float*)in[i]; }
    HD const int* pos() const { return (const int*)in[I_POS]; }
    template <class Tp> HD Tp* w(size_t off) const { return (Tp*)(ws + off); }
    HD float* mod(int l, int b, int part) const { return w<float>(WS_MOD) + ((size_t)(l * NB + b) * 6 + part) * D_; }
    HD int* cnt(int l) const { return w<int>(WS_CTL) + CW_CNT + l * NE; }
};

#ifdef HOSTTEST
#define ATOMIC_ADD_I32(p, v) __atomic_fetch_add((p), (v), __ATOMIC_RELAXED)
#else
#define ATOMIC_ADD_I32(p, v) atomicAdd((p), (v))
#endif


HD void ph_prologue(const Ctx& C, long gt, long gs) {
    for (long it = gt; it < (long)DEPTH * 6 * D_; it += gs) {
        const int l = (int)(it / (6 * D_)), j = (int)(it % (6 * D_));
        float acc[NB];
#pragma unroll
        for (int b = 0; b < NB; ++b) acc[b] = 0.f;
        const float* W = C.f(I_ADA_W) + (size_t)l * D_ * 6 * D_ + j;
        const float* cc = C.f(I_C);
        for (int k = 0; k < D_; ++k) {
            const float wv = W[(size_t)k * 6 * D_];
#pragma unroll
            for (int b = 0; b < NB; ++b) acc[b] += siluf_(cc[b * D_ + k]) * wv;
        }
        const float bias = C.f(I_ADA_B)[l * 6 * D_ + j];
#pragma unroll
        for (int b = 0; b < NB; ++b) C.w<float>(WS_MOD)[(size_t)(l * NB + b) * 6 * D_ + j] = acc[b] + bias;
    }
    for (long it = gt; it < (long)T_ * 128; it += gs) {
        const int t = (int)(it >> 7), i = (int)(it & 127);
        const float inv = exp2f(-(float)(2 * i) / 256.0f * 13.287712379549449f);
        const float ang = (float)C.pos()[t] * inv; float s, c; sincos_acc(ang, s, c);
        C.w<float>(WS_COS256)[it] = c; C.w<float>(WS_SIN256)[it] = s;
    }
    for (long it = gt; it < (long)T_ * 32; it += gs) {
        const int t = (int)(it >> 5), i = (int)(it & 31);
        const float inv = exp2f(-(float)(2 * i) / 64.0f * 13.287712379549449f);
        const float ang = (float)C.pos()[t] * inv; float s, c; sincos_acc(ang, s, c);
        C.w<float>(WS_COS64)[it] = c; C.w<float>(WS_SIN64)[it] = s;
    }
    for (long it = gt; it < 512; it += gs) {
        const int tz = (int)(it >> 8), j = (int)(it & 255);
        const float* pe = C.f(tz ? I_NSA_POS_V : I_NSA_POS_K); const float* w1 = C.f(tz ? I_NSA_V_W1 : I_NSA_K_W1);
        float a = 0.f;
        for (int i = 0; i < 2048; ++i) a += pe[i] * w1[(size_t)i * 256 + j];
        C.w<float>(WS_CB)[it] = a;
    }
}

HD void ph_modx0(const Ctx& C, long gt, long gs) {
    const float* x = C.f(I_X);
    for (long it = gt; it < (long)T_ * D_; it += gs) {
        const int t = (int)(it / D_), c = (int)(it % D_), b = t / S_;
        C.w<bf16>(WS_H)[it] = f2bf(x[it] * (1.0f + C.mod(0, b, 1)[c]) + C.mod(0, b, 0)[c]);
    }
}

HD void ph_ln(const Ctx& C, int l, int which, long gt, long gs) {
    const float* xsrc = (l == 0 && which == 0) ? C.f(I_X) : C.out;
    const float* lg = C.f(which ? I_LN2_G : I_LN1_G) + l * D_; const float* lb = C.f(which ? I_LN2_B : I_LN1_B) + l * D_;
    for (long t = gt; t < T_; t += gs) {
        const int b = (int)(t / S_);
        const float* xr = xsrc + (size_t)t * D_;
        const float* gate = C.mod(l, b, which ? 5 : 2);
        const bf16* y0 = which ? C.w<bf16>(WS_YS) + (size_t)t * 4 * D_ : C.w<bf16>(WS_Y) + (size_t)t * D_;
        float w0 = 1.f, w1 = 0.f, w2 = 0.f, w3 = 0.f;
        if (which) { const float* tw = C.w<float>(WS_TOPW) + (size_t)t * 4; w0 = tw[0]; w1 = tw[1]; w2 = tw[2]; w3 = tw[3]; }
#define LN_V(c) (DN_ALPHA * xr[c] + (1.0f + gate[c]) * (which ? (w0 * bf2f(y0[c]) + w1 * bf2f(y0[D_ + (c)]) + w2 * bf2f(y0[2 * D_ + (c)]) + w3 * bf2f(y0[3 * D_ + (c)])) : bf2f(y0[c])))
        float s = 0.f;
        for (int c = 0; c < D_; ++c) s += LN_V(c);
        const float mu = s * (1.0f / D_);
        float q = 0.f;
        for (int c = 0; c < D_; ++c) { const float d = LN_V(c) - mu; q += d * d; }
        const float rstd = 1.0f / sqrtf(q * (1.0f / D_) + LN_EPS);
        const bool has_next = which == 0 || l + 1 < DEPTH;
        const int nl = which ? l + 1 : l;
        const float* sh = has_next ? C.mod(nl, b, which ? 0 : 3) : nullptr; const float* sc = has_next ? C.mod(nl, b, which ? 1 : 4) : nullptr;
        float lgt[NE];
#pragma unroll
        for (int e = 0; e < NE; ++e) lgt[e] = 0.f;
        const float* rw = C.f(I_ROUTER_W) + (size_t)l * D_ * NE;
        float* xo = C.out + (size_t)t * D_; bf16* ho = C.w<bf16>(WS_H) + (size_t)t * D_;
        for (int c = 0; c < D_; ++c) {
            const float xn = (LN_V(c) - mu) * rstd * lg[c] + lb[c];
            xo[c] = xn;
            if (has_next) {
                const float h = xn * (1.0f + sc[c]) + sh[c];
                ho[c] = f2bf(h);
                if (which == 0) {
#pragma unroll
                    for (int e = 0; e < NE; ++e) lgt[e] += h * rw[c * NE + e];
                }
            }
        }
#undef LN_V
        if (which == 0) {
            const float* rb = C.f(I_ROUTER_B) + l * NE;
#pragma unroll
            for (int e = 0; e < NE; ++e) lgt[e] += rb[e];
            int ti[4]; float tv[4];
#pragma unroll
            for (int kk = 0; kk < 4; ++kk) {
                float best = -3.0e38f; int bi = 0;
#pragma unroll
                for (int e = 0; e < NE; ++e) if (lgt[e] > best) { best = lgt[e]; bi = e; }
                tv[kk] = best; ti[kk] = bi;
#pragma unroll
                for (int e = 0; e < NE; ++e) if (e == bi) lgt[e] = -3.3e38f;
            }
            const float e1 = expf(tv[1] - tv[0]), e2 = expf(tv[2] - tv[0]), e3 = expf(tv[3] - tv[0]);
            const float inv = 1.0f / (1.0f + e1 + e2 + e3);
            float* tw = C.w<float>(WS_TOPW) + (size_t)t * 4;
            tw[0] = inv; tw[1] = e1 * inv; tw[2] = e2 * inv; tw[3] = e3 * inv;
#pragma unroll
            for (int kk = 0; kk < 4; ++kk) {
                const int p = ATOMIC_ADD_I32(C.cnt(l) + ti[kk], 1);
                C.w<int>(WS_LIST)[(size_t)ti[kk] * T_ + p] = (int)t * 4 + kk;
            }
        }
    }
}

HD void ph_moe_act(const Ctx& C, long gt, long gs) {
    const bf16* gu = C.w<bf16>(WS_GU); bf16* act = C.w<bf16>(WS_ACT);
    for (long it = gt; it < (long)T_ * 4 * DFF; it += gs) {
        const long slot = it / DFF; const int c = (int)(it % DFF);
        float g = bf2f(gu[slot * 2 * DFF + c]), up = bf2f(gu[slot * 2 * DFF + DFF + c]);
        g = fminf(g, SW_LIMIT); up = fminf(fmaxf(up, -SW_LIMIT), SW_LIMIT);
        act[it] = f2bf((up + 1.0f) * (g * sigmoidf_(SW_ALPHA * g)));
    }
}

HD float ret_lg(int h) { return log1pf(-exp2f(-5.0f - (float)h)); }
HD void ph_ret_rope(const Ctx& C, long gt, long gs) {
    bf16* z = C.w<bf16>(WS_QKVG);
    for (long it = gt; it < (long)T_ * 2 * RH * 128; it += gs) {
        const int i = (int)(it & 127); long r = it >> 7; const int hh = (int)(r % (2 * RH)); const long t = r / (2 * RH);
        bf16* p = z + t * RW + hh * RDK;
        const float cs = C.w<float>(WS_COS256)[t * 128 + i], sn = C.w<float>(WS_SIN256)[t * 128 + i];
        const float x1 = bf2f(p[i]), x2 = bf2f(p[i + 128]); const float sc = hh >= RH ? 0.0625f : 1.0f;
        p[i] = f2bf((x1 * cs - x2 * sn) * sc); p[i + 128] = f2bf((x1 * sn + x2 * cs) * sc);
    }
}
HD void ph_ret_p(const Ctx& C, long gt, long gs) {
    const bf16* z = C.w<bf16>(WS_QKVG); float* P = C.w<float>(WS_RP);
    for (long it = gt; it < (long)T_ * RH * RCH; it += gs) {
        const int j = (int)(it % RCH); long r = it / RCH; const int h = (int)(r % RH); const long t = r / RH;
        const int i = (int)(t % RCH); float v = 0.f;
        if (j <= i) {
            const bf16* q = z + t * RW + h * RDK; const bf16* k = z + (t - i + j) * RW + RH * RDK + h * RDK;
            float a = 0.f;
            for (int d = 0; d < RDK; ++d) a += bf2f(q[d]) * bf2f(k[d]);
            v = a * expf(ret_lg(h) * (float)(i - j));
        }
        P[it] = v;
    }
}
HD void ph_ret_state(const Ctx& C, long gt, long gs) {
    const bf16* z = C.w<bf16>(WS_QKVG); float* ST = C.w<float>(WS_RST);
    for (long it = gt; it < (long)NB * RH * RDK * RDV; it += gs) {
        const int v = (int)(it % RDV); long r = it / RDV; const int d = (int)(r % RDK); r /= RDK; const int h = (int)(r % RH); const int b = (int)(r / RH);
        const float lg = ret_lg(h), dc = expf(lg * (float)RCH);
        float s = 0.f;
        for (int n = 0; n < RNCH - 1; ++n) {
            float a = 0.f;
            for (int j = 0; j < RCH; ++j) {
                const size_t row = ((size_t)b * S_ + n * RCH + j) * RW;
                a += bf2f(z[row + RH * RDK + h * RDK + d]) * expf(lg * (float)(RCH - 1 - j)) * bf2f(z[row + 2 * RH * RDK + h * RDV + v]);
            }
            s = s * dc + a;
            ST[(size_t)n * NB * RH * RDK * RDV + it] = s;
        }
    }
}
HD void ph_ret_o(const Ctx& C, long gt, long gs) {
    const bf16* z = C.w<bf16>(WS_QKVG); const float* P = C.w<float>(WS_RP); const float* ST = C.w<float>(WS_RST); bf16* O = C.w<bf16>(WS_RO);
    for (long it = gt; it < (long)T_ * RH * RDV; it += gs) {
        const int v = (int)(it % RDV); long r = it / RDV; const int h = (int)(r % RH); const long t = r / RH;
        const int b = (int)(t / S_), s = (int)(t % S_), i = s % RCH, n = s / RCH;
        float a = 0.f;
        const float* p = P + (t * RH + h) * RCH;
        for (int j = 0; j <= i; ++j) a += p[j] * bf2f(z[(t - i + j) * RW + 2 * RH * RDK + h * RDV + v]);
        if (n > 0) {
            const float* st = ST + (size_t)(n - 1) * NB * RH * RDK * RDV + ((size_t)(b * RH + h) * RDK) * RDV + v;
            const bf16* q = z + t * RW + h * RDK; float c = 0.f;
            for (int d = 0; d < RDK; ++d) c += bf2f(q[d]) * st[(size_t)d * RDV];
            a += c * expf(ret_lg(h) * (float)(i + 1));
        }
        O[it] = f2bf(a);
    }
}
HD void ph_ret_gn(const Ctx& C, long gt, long gs) {
    const bf16* z = C.w<bf16>(WS_QKVG); const bf16* O = C.w<bf16>(WS_RO); bf16* A2 = C.w<bf16>(WS_RA2);
    const float* gg = C.f(I_RET_GN_G); const float* gb = C.f(I_RET_GN_B);
    for (long it = gt; it < (long)T_ * RH; it += gs) {
        const int h = (int)(it % RH); const long t = it / RH;
        const bf16* o = O + (t * RH + h) * RDV;
        float s = 0.f; for (int v = 0; v < RDV; ++v) s += bf2f(o[v]);
        const float mu = s / RDV; float q = 0.f;
        for (int v = 0; v < RDV; ++v) { const float d = bf2f(o[v]) - mu; q += d * d; }
        const float rstd = 1.0f / sqrtf(q / RDV + LN_EPS);
        const bf16* g = z + t * RW + 2 * RH * RDK + RH * RDV + h * RDV;
        for (int v = 0; v < RDV; ++v) A2[(t * RH + h) * RDV + v] = f2bf(siluf_(bf2f(g[v])) * ((bf2f(o[v]) - mu) * rstd * gg[h * RDV + v] + gb[h * RDV + v]));
    }
}

HD void ph_conv_glu(const Ctx& C, long gt, long gs) {
    const bf16* raw = C.w<bf16>(WS_CRAW); bf16* U = C.w<bf16>(WS_CU);
    for (long it = gt; it < (long)T_ * D_; it += gs) { const long t = it / D_; const int c = (int)(it % D_);
        U[it] = f2bf(bf2f(raw[t * 2 * D_ + c]) * sigmoidf_(bf2f(raw[t * 2 * D_ + D_ + c]))); }
}
HD void ph_conv_dw(const Ctx& C, long gt, long gs) {
    const bf16* U = C.w<bf16>(WS_CU); float* CV = C.w<float>(WS_CCV); const float* wd = C.f(I_CONV_W_DW); const float* bd = C.f(I_CONV_B_DW);
    for (long it = gt; it < (long)T_ * D_; it += gs) { const long t = it / D_; const int c = (int)(it % D_); const int s = (int)(t % S_);
        float a = bd[c];
        for (int w = 0; w < CW; ++w) { const int sp = s - (CW - 1) + w; if (sp >= 0) a += bf2f(U[(t - (CW - 1) + w) * D_ + c]) * wd[w * D_ + c]; }
        CV[it] = a; }
}
HD void ph_conv_ln(const Ctx& C, long gt, long gs) {
    const float* CV = C.w<float>(WS_CCV); bf16* A2 = C.w<bf16>(WS_CA2); const float* g = C.f(I_CONV_LN_G); const float* bb = C.f(I_CONV_LN_B);
    for (long t = gt; t < T_; t += gs) { const float* r = CV + t * D_;
        float s = 0.f; for (int c = 0; c < D_; ++c) s += r[c];
        const float mu = s / D_; float q = 0.f; for (int c = 0; c < D_; ++c) { const float d = r[c] - mu; q += d * d; }
        const float rstd = 1.0f / sqrtf(q / D_ + LN_EPS);
        for (int c = 0; c < D_; ++c) A2[t * D_ + c] = f2bf(siluf_((r[c] - mu) * rstd * g[c] + bb[c])); }
}

HD void ph_pool(const Ctx& C, long gt, long gs) {
    const bf16* H = C.w<bf16>(WS_H); bf16* PL = C.w<bf16>(WS_PL);
    for (long it = gt; it < (long)T_ * D_; it += gs) { const long t = it / D_; const int c = (int)(it % D_); const int s = (int)(t % S_);
        const int win = 2 << (c >> 8); const int lo = s + 1 - win > 0 ? s + 1 - win : 0; float a = 0.f;
        for (int sp = lo; sp <= s; ++sp) a += bf2f(H[(t - s + sp) * D_ + c]);
        PL[it] = f2bf(a / (float)(s + 1 - lo) - bf2f(H[it])); }
}

HD void ph_nsa_rope(const Ctx& C, long gt, long gs) {
    bf16* Q = C.w<bf16>(WS_NQ); bf16* KV = C.w<bf16>(WS_NKV);
    for (long it = gt; it < (long)T_ * 22 * 32; it += gs) {
        const int i = (int)(it & 31); long r = it >> 5; const int hh = (int)(r % 22); const long t = r / 22;
        bf16* p; float sc = 1.0f;
        if (hh < 16) { p = Q + t * D_ + hh * 64; sc = 0.125f; } else { const int k3 = (hh - 16) >> 1, g = (hh - 16) & 1; p = KV + t * NKVW + k3 * 256 + g * 64; }
        const float cs = C.w<float>(WS_COS64)[t * 32 + i], sn = C.w<float>(WS_SIN64)[t * 32 + i];
        const float x1 = bf2f(p[i]), x2 = bf2f(p[i + 32]);
        p[i] = f2bf((x1 * cs - x2 * sn) * sc); p[i + 32] = f2bf((x1 * sn + x2 * cs) * sc);
    }
}
HD int nsa_nvalid_cmp(int s) { int nv = s >= 31 ? (s - 31) / 16 + 1 : 0; return nv > NCMP ? NCMP : nv; }
HD void ph_nsa_cmp_attn(const Ctx& C, long gt, long gs) {
    const bf16* Q = C.w<bf16>(WS_NQ); const bf16* CKV = C.w<bf16>(WS_CMPKV); float* PC = C.w<float>(WS_PC); float* OC = C.w<float>(WS_OC);
    for (long it = gt; it < (long)T_ * NH; it += gs) {
        const int hd = (int)(it % NH); const long t = it / NH; const int b = (int)(t / S_), s = (int)(t % S_), g = hd / NR; const int nv = nsa_nvalid_cmp(s);
        float q[64], o[64];
#pragma unroll
        for (int d = 0; d < 64; ++d) { q[d] = bf2f(Q[t * D_ + hd * 64 + d]); o[d] = 0.f; }
        const bf16* kc = CKV + ((size_t)(b * NG + g) * 256) * 64; const bf16* vc = CKV + ((size_t)(NBG + b * NG + g) * 256) * 64;
        float mx = -3.0e38f;
        for (int n = 0; n < nv; ++n) { float a = 0.f;
#pragma unroll
            for (int d = 0; d < 64; ++d) a += q[d] * bf2f(kc[n * 64 + d]);
            mx = fmaxf(mx, a); }
        float sum = 0.f;
        for (int n = 0; n < nv; ++n) { float a = 0.f;
#pragma unroll
            for (int d = 0; d < 64; ++d) a += q[d] * bf2f(kc[n * 64 + d]);
            sum += expf(a - mx); }
        const float inv = nv > 0 ? 1.0f / sum : 0.f;
        for (int n = 0; n < nv; ++n) { float a = 0.f;
#pragma unroll
            for (int d = 0; d < 64; ++d) a += q[d] * bf2f(kc[n * 64 + d]);
            const float p = expf(a - mx) * inv; PC[it * 256 + n] = p;
#pragma unroll
            for (int d = 0; d < 64; ++d) o[d] += p * bf2f(vc[n * 64 + d]); }
#pragma unroll
        for (int d = 0; d < 64; ++d) OC[t * D_ + hd * 64 + d] = o[d];
    }
}
HD void ph_nsa_select(const Ctx& C, long gt, long gs) {
    const float* PC = C.w<float>(WS_PC); float* IMP = C.w<float>(WS_IMP); u64* SELM = C.w<u64>(WS_SELM);
    for (long it = gt; it < (long)T_ * NG; it += gs) {
        const int g = (int)(it % NG); const long t = it / NG; const int s = (int)(t % S_), cur = s / 64, nv = nsa_nvalid_cmp(s);
        float* imp = IMP + it * 64;
        for (int j = 0; j <= cur; ++j) {
            float a;
            if (j == 0 || j == cur || j == cur - 1) a = 1.0e6f;
            else { a = 0.f; int n0 = 4 * j - 1, n1 = 4 * j + 3; if (n0 < 0) n0 = 0; if (n1 > nv - 1) n1 = nv - 1;
                for (int r = 0; r < NR; ++r) for (int n = n0; n <= n1; ++n) a += PC[(t * NH + g * NR + r) * 256 + n]; }
            imp[j] = a;
        }
        const int nsel = (cur + 1) < KSEL ? (cur + 1) : KSEL; u64 taken = 0;
        for (int p = 0; p < nsel; ++p) { float best = -3.0e38f; int bj = 0;
            for (int j = 0; j <= cur; ++j) if (!((taken >> j) & 1ull)) { const float v = imp[j]; if (v > best) { best = v; bj = j; } }
            taken |= 1ull << bj; }
        SELM[it] = taken;
    }
}
HD void ph_nsa_attn(const Ctx& C, long gt, long gs) {
    const bf16* Q = C.w<bf16>(WS_NQ); const bf16* KV = C.w<bf16>(WS_NKV); const float* OC = C.w<float>(WS_OC); const u64* SELM = C.w<u64>(WS_SELM);
    const float* GT = C.w<float>(WS_NGT); bf16* NO = C.w<bf16>(WS_NO);
    for (long it = gt; it < (long)T_ * NH; it += gs) {
        const int hd = (int)(it % NH); const long t = it / NH; const int s = (int)(t % S_), g = hd / NR, cur = s / 64; const long tb = t - s;
        float q[64], o[64], o2[64];
#pragma unroll
        for (int d = 0; d < 64; ++d) { q[d] = bf2f(Q[t * D_ + hd * 64 + d]); o[d] = 0.f; o2[d] = 0.f; }
        const u64 sel = SELM[t * NG + g];
        float m = -3.0e38f, l = 0.f;
        for (int j = 0; j <= cur; ++j) if ((sel >> j) & 1ull) {
            const int kend = (64 * j + 63) < s ? (64 * j + 63) : s;
            for (int kp = 64 * j; kp <= kend; ++kp) {
                const bf16* kr = KV + (tb + kp) * NKVW + 256 + g * 64; const bf16* vr = KV + (tb + kp) * NKVW + 384 + g * 64;
                float a = 0.f;
#pragma unroll
                for (int d = 0; d < 64; ++d) a += q[d] * bf2f(kr[d]);
                const float mn = fmaxf(m, a), corr = expf(m - mn), p = expf(a - mn);
                l = l * corr + p; m = mn;
#pragma unroll
                for (int d = 0; d < 64; ++d) o[d] = o[d] * corr + p * bf2f(vr[d]);
            }
        }
        float m2 = -3.0e38f, l2 = 0.f;
        for (int kp = (s - (NWIN - 1) > 0 ? s - (NWIN - 1) : 0); kp <= s; ++kp) {
            const bf16* kr = KV + (tb + kp) * NKVW + 512 + g * 64; const bf16* vr = KV + (tb + kp) * NKVW + 640 + g * 64;
            float a = 0.f;
#pragma unroll
            for (int d = 0; d < 64; ++d) a += q[d] * bf2f(kr[d]);
            const float mn = fmaxf(m2, a), corr = expf(m2 - mn), p = expf(a - mn);
            l2 = l2 * corr + p; m2 = mn;
#pragma unroll
            for (int d = 0; d < 64; ++d) o2[d] = o2[d] * corr + p * bf2f(vr[d]);
        }
        const float gc = GT[t * 48 + hd * 3 + 0], gs_ = GT[t * 48 + hd * 3 + 1] / l, gw = GT[t * 48 + hd * 3 + 2] / l2;
#pragma unroll
        for (int d = 0; d < 64; ++d) NO[t * D_ + hd * 64 + d] = f2bf(gc * OC[t * D_ + hd * 64 + d] + gs_ * o[d] + gw * o2[d]);
    }
}

struct GBase { int Z, MT  , N, K; };
struct G_Dense : GBase {
    const bf16* A; int lda; const float* W; int ldw; const float* bias; bf16* O; int ldo;
    HD int rows(int) const { return T_; }
    HD float Af(int, int m, int k) const { return bf2f(A[(size_t)m * lda + k]); }
    HD float Bf(int, int k, int n) const { return W[(size_t)k * ldw + n]; }
    HD void epi(int, int m, int n, float v) const { O[(size_t)m * ldo + n] = f2bf(v + (bias ? bias[n] : 0.f)); }
};
struct G_NsaIn : GBase {
    const bf16* A; const float* W; bf16* Q; bf16* KV; float* GT; const float* gate_b;
    HD int rows(int) const { return T_; }
    HD float Af(int, int m, int k) const { return bf2f(A[(size_t)m * D_ + k]); }
    HD float Bf(int, int k, int n) const { return W[(size_t)k * NINW + n]; }
    HD void epi(int, int m, int n, float v) const {
        if (n < 1024) Q[(size_t)m * D_ + n] = f2bf(v); else if (n < 1792) KV[(size_t)m * NKVW + (n - 1024)] = f2bf(v); else GT[(size_t)m * 48 + (n - 1792)] = sigmoidf_(v + gate_b[n - 1792]); }
};
struct G_Cmp1 : GBase {
    const bf16* KV; const float* w1k; const float* w1v; const float* cb; bf16* H;
    HD int rows(int) const { return NCMP; }
    HD float Af(int z, int m, int k) const { const int tz = z / NBG, bg = z % NBG, b = bg / NG, g = bg % NG; return bf2f(KV[((size_t)b * S_ + 16 * m + (k >> 6)) * NKVW + tz * 128 + g * 64 + (k & 63)]); }
    HD float Bf(int z, int k, int n) const { return (z / NBG ? w1v : w1k)[(size_t)k * 256 + n]; }
    HD void epi(int z, int m, int n, float v) const { H[((size_t)z * 256 + m) * 256 + n] = f2bf(gelu_tanh(v + cb[(z / NBG) * 256 + n])); }
};
struct G_Cmp2 : GBase {
    const bf16* H; const float* w2k; const float* w2v; bf16* O;
    HD int rows(int) const { return NCMP; }
    HD float Af(int z, int m, int k) const { return bf2f(H[((size_t)z * 256 + m) * 256 + k]); }
    HD float Bf(int z, int k, int n) const { return (z / NBG ? w2v : w2k)[(size_t)k * 64 + n]; }
    HD void epi(int z, int m, int n, float v) const { O[((size_t)z * 256 + m) * 64 + n] = f2bf(v); }
};
struct G_Pool : GBase {
    const bf16* PL; const float* W; const float* pb; const float* ps; bf16* Y;
    HD int rows(int) const { return T_; }
    HD float Af(int z, int m, int k) const { return bf2f(PL[(size_t)m * D_ + z * 256 + k]); }
    HD float Bf(int z, int k, int n) const { return W[((size_t)z * 256 + k) * 256 + n]; }
    HD void epi(int z, int m, int n, float v) const { const int c = z * 256 + n; Y[(size_t)m * D_ + c] = f2bf((v + pb[c]) * ps[c]); }
};
struct G_MoeUp : GBase {
    const bf16* Hh; const int* list; const int* cnt; const float* W; const float* b1; bf16* GU;
    HD int rows(int z) const { return cnt[z]; }
    HD float Af(int z, int m, int k) const { return bf2f(Hh[(size_t)(list[(size_t)z * T_ + m] >> 2) * D_ + k]); }
    HD float Bf(int z, int k, int n) const { return W[((size_t)z * D_ + k) * 2 * DFF + n]; }
    HD void epi(int z, int m, int n, float v) const { GU[(size_t)list[(size_t)z * T_ + m] * 2 * DFF + n] = f2bf(v + b1[z * 2 * DFF + n]); }
};
struct G_MoeDown : GBase {
    const bf16* ACT; const int* list; const int* cnt; const float* W; const float* b2; bf16* YS;
    HD int rows(int z) const { return cnt[z]; }
    HD float Af(int z, int m, int k) const { return bf2f(ACT[(size_t)list[(size_t)z * T_ + m] * DFF + k]); }
    HD float Bf(int z, int k, int n) const { return W[((size_t)z * DFF + k) * D_ + n]; }
    HD void epi(int z, int m, int n, float v) const { YS[(size_t)list[(size_t)z * T_ + m] * D_ + n] = f2bf(v + b2[z * D_ + n]); }
};

HD G_Dense mk_dense(const bf16* A, int lda, const float* W, int K, int N, const float* bias, bf16* O, int ldo) {
    G_Dense g; g.Z = 1; g.MT = T_ / 128; g.N = N; g.K = K; g.A = A; g.lda = lda; g.W = W; g.ldw = N; g.bias = bias; g.O = O; g.ldo = ldo; return g; }

#ifdef HOSTTEST
template <class G> void gemm_host(const G& g) {
    for (int z = 0; z < g.Z; ++z) {
        const int rows = g.rows(z); if (rows <= 0) continue;
        float* Bz = (float*)malloc((size_t)g.K * g.N * 4);
        for (int k = 0; k < g.K; ++k) for (int n = 0; n < g.N; ++n) Bz[(size_t)k * g.N + n] = bfr(g.Bf(z, k, n));
#pragma omp parallel
        {
            float* ar = (float*)malloc(g.K * 4); float* acc = (float*)malloc(g.N * 4);
#pragma omp for schedule(dynamic, 8)
            for (int m = 0; m < rows; ++m) {
                for (int k = 0; k < g.K; ++k) ar[k] = bfr(g.Af(z, m, k));
                for (int n = 0; n < g.N; ++n) acc[n] = 0.f;
                for (int k = 0; k < g.K; ++k) { const float a = ar[k]; const float* br = Bz + (size_t)k * g.N; for (int n = 0; n < g.N; ++n) acc[n] += a * br[n]; }
                for (int n = 0; n < g.N; ++n) g.epi(z, m, n, acc[n]);
            }
            free(ar); free(acc);
        }
        free(Bz);
    }
}
#define GEMM(g) gemm_host(g)
#include <omp.h>
#define PHASE(call_with_gt_gs) do { _Pragma("omp parallel") { const long gt = omp_get_thread_num(), gs = omp_get_num_threads(); call_with_gt_gs; } } while (0)
#else
#define GAS __attribute__((address_space(1)))
#define LAS __attribute__((address_space(3)))
typedef short bf16x8 __attribute__((ext_vector_type(8)));
typedef float f32x4 __attribute__((ext_vector_type(4)));
typedef unsigned u32x4 __attribute__((ext_vector_type(4)));
typedef unsigned u32x2 __attribute__((ext_vector_type(2)));
constexpr int NTHREADS = 512;
constexpr int LDS_BYTES = 147456;
constexpr int LDS_MISC = LDS_BYTES - 256;

template <class G> __device__ __forceinline__ void gemm_naive(const G& g, LAS unsigned char* lds) {
    int tid_ = threadIdx.x; asm volatile("" : "+v"(tid_)); const int tid = tid_, lane = tid & 63, w = tid >> 6, wm = w >> 2, wn = w & 3, fr = lane & 15, fq = lane >> 4;
    LAS bf16* As = (LAS bf16*)lds; LAS bf16* Bs = As + 128 * 40;
    const int NT = (g.N + 127) / 128; const long ntiles = (long)g.Z * g.MT * NT;
    const int ar = tid >> 2, aks = (tid & 3) * 8, bn = tid & 127, bks = (tid >> 7) * 8;
    for (long tile = blockIdx.x; tile < ntiles; tile += gridDim.x) {
        const int mt = (int)(tile % g.MT); const long r = tile / g.MT; const int nt = (int)(r % NT), z = (int)(r / NT);
        const int rows = g.rows(z), m0 = mt * 128, n0 = nt * 128;
        if (m0 >= rows) continue;
        f32x4 acc[4][2];
#pragma unroll
        for (int i = 0; i < 4; ++i)
#pragma unroll
            for (int j = 0; j < 2; ++j) acc[i][j] = (f32x4){0.f, 0.f, 0.f, 0.f};
        for (int k0 = 0; k0 < g.K; k0 += 32) {
            { const int m = m0 + ar; bf16x8 v;
#pragma unroll
              for (int j = 0; j < 8; ++j) v[j] = (m < rows) ? (short)f2bf(g.Af(z, m, k0 + aks + j)) : (short)0;
              *(LAS bf16x8*)(As + ar * 40 + aks) = v; }
            { const int n = n0 + bn; bf16x8 v;
#pragma unroll
              for (int j = 0; j < 8; ++j) v[j] = (n < g.N) ? (short)f2bf(g.Bf(z, k0 + bks + j, n)) : (short)0;
              *(LAS bf16x8*)(Bs + bn * 40 + bks) = v; }
            __syncthreads();
            bf16x8 af[4], bq[2];
#pragma unroll
            for (int i = 0; i < 4; ++i) af[i] = *(LAS bf16x8*)(As + (wm * 64 + i * 16 + fr) * 40 + fq * 8);
#pragma unroll
            for (int j = 0; j < 2; ++j) bq[j] = *(LAS bf16x8*)(Bs + (wn * 32 + j * 16 + fr) * 40 + fq * 8);
#pragma unroll
            for (int i = 0; i < 4; ++i)
#pragma unroll
                for (int j = 0; j < 2; ++j) acc[i][j] = __builtin_amdgcn_mfma_f32_16x16x32_bf16(af[i], bq[j], acc[i][j], 0, 0, 0);
            __syncthreads();
        }
#pragma unroll
        for (int i = 0; i < 4; ++i)
#pragma unroll
            for (int j = 0; j < 2; ++j)
#pragma unroll
                for (int rr = 0; rr < 4; ++rr) { const int row = m0 + wm * 64 + i * 16 + fq * 4 + rr, col = n0 + wn * 32 + j * 16 + fr;
                    if (row < rows && col < g.N) g.epi(z, row, col, acc[i][j][rr]); }
    }
}
#define GEMM(g) gemm_naive(g, lds)
#define PHASE(call_with_gt_gs) do { call_with_gt_gs; } while (0)

#define XB_TMO      128
#define XB_XCNT(j)  (256  + 64 * (j))
#define XB_XSUB(j)  (1280 + 64 * (j))
#define XB_XGEN(j)  (2304 + 64 * (j))
#define XB_TOP      3328
#define XB_TOPGEN   3392
#define XCD_BAR_WORDS 3456
#define XB_SPIN_CAP (1u << 24)
__device__ __forceinline__ unsigned xb_ld(unsigned* p)              { return __hip_atomic_load(p, __ATOMIC_RELAXED, __HIP_MEMORY_SCOPE_AGENT); }
__device__ __forceinline__ unsigned xb_add(unsigned* p, unsigned v) { return __hip_atomic_fetch_add(p, v, __ATOMIC_RELAXED, __HIP_MEMORY_SCOPE_AGENT); }
__device__ __forceinline__ unsigned xb_xcc_id() { return (unsigned)__builtin_amdgcn_s_getreg((3 << 11) | 20) & 0xFu; }
#define XB_SPIN(cond, bar) do { unsigned _sp = 0; while (cond) { __builtin_amdgcn_s_sleep(1); \
    if ((++_sp & 255u) == 0u) { if (xb_ld(&(bar)[XB_TMO])) break; if (_sp > XB_SPIN_CAP) { atomicAdd(&(bar)[XB_TMO], 1u); break; } } } } while (0)
struct XcdBarrier { unsigned* bar; unsigned x; volatile LAS unsigned* st; };
__device__ __forceinline__ XcdBarrier xcd_barrier_post(unsigned* bar, volatile LAS unsigned* st) {
    XcdBarrier b; b.bar = bar; b.x = xb_xcc_id(); b.st = st;
    if (threadIdx.x == 0) (void)xb_add(&bar[XB_XCNT(b.x)], 1u);
    return b;
}
__device__ __forceinline__ void xcd_barrier_complete(unsigned* bar, unsigned x, unsigned& nloc, unsigned& nx) {
    const unsigned G = gridDim.x * gridDim.y * gridDim.z;
    unsigned sum, cnt, mine, sp = 0u;
    for (;;) {
        sum = 0u; cnt = 0u; mine = 0u;
#pragma unroll
        for (unsigned j = 0; j < 16; ++j) { const unsigned c = xb_ld(&bar[XB_XCNT(j)]); sum += c; cnt += (c > 0u) ? 1u : 0u; mine = (j == x) ? c : mine; }
        if (sum == G) break;
        __builtin_amdgcn_s_sleep(1);
        if ((++sp & 255u) == 0u) { if (xb_ld(&bar[XB_TMO])) break; if (sp > XB_SPIN_CAP) { atomicAdd(&bar[XB_TMO], 1u); break; } }
    }
    nloc = mine > 0u ? mine : 1u; nx = cnt > 0u ? cnt : 1u;
}
__device__ __forceinline__ void xcd_barrier(const XcdBarrier& b) {
    asm volatile("s_waitcnt vmcnt(0)" ::: "memory");
    __syncthreads();
    if (threadIdx.x == 0) {
        unsigned* bar = b.bar;
        __builtin_amdgcn_s_waitcnt(0);
        unsigned nloc = b.st[0], nx = b.st[1];
        if (nloc == 0u) { xcd_barrier_complete(bar, b.x, nloc, nx); b.st[0] = nloc; b.st[1] = nx; }
        const unsigned old = xb_add(&bar[XB_XSUB(b.x)], 1u);
        const unsigned gen = old / nloc;
        if (old + 1u == (gen + 1u) * nloc) {
            __builtin_amdgcn_fence(__ATOMIC_RELEASE, "agent");
            asm volatile("s_waitcnt vmcnt(0)" ::: "memory");
            const unsigned og = xb_add(&bar[XB_TOP], 1u);
            const unsigned tg = og / nx;
            if (og + 1u == (tg + 1u) * nx) xb_add(&bar[XB_TOPGEN], 1u);
            else XB_SPIN(xb_ld(&bar[XB_TOPGEN]) == tg, bar);
            __builtin_amdgcn_fence(__ATOMIC_ACQUIRE, "agent");
            xb_add(&bar[XB_XGEN(b.x)], 1u);
            asm volatile("s_waitcnt vmcnt(0)" ::: "memory");
        } else {
            XB_SPIN(xb_ld(&bar[XB_XGEN(b.x)]) == gen, bar);
            __builtin_amdgcn_fence(__ATOMIC_ACQUIRE, "agent");
            asm volatile("s_waitcnt vmcnt(0)" ::: "memory");
        }
    }
    __syncthreads();
}
#endif


#ifndef HOSTTEST
__device__ __forceinline__ unsigned cvt_pk_bf16(float lo, float hi) { unsigned r; asm volatile("v_cvt_pk_bf16_f32 %0, %1, %2" : "=v"(r) : "v"(lo), "v"(hi)); return r; }
__device__ __forceinline__ float fast_sigmoid(float x) { return __builtin_amdgcn_rcpf(1.0f + __builtin_amdgcn_exp2f(-1.4426950408889634f * x)); }

constexpr float KREP = (PROBE_KIND == 10) ? 2.0f : 1.0f;
constexpr float W1_SCALE = 64.0f * KREP, W2_SCALE = 128.0f * KREP, ACT_SCALE = 8.0f, YC_SCALE = 32.0f;
typedef float f32x2_ __attribute__((ext_vector_type(2)));
__device__ __forceinline__ f32x4 fp8x4(int p) { const f32x2_ lo = __builtin_amdgcn_cvt_pk_f32_fp8(p, false), hi = __builtin_amdgcn_cvt_pk_f32_fp8(p, true); return (f32x4){lo[0], lo[1], hi[0], hi[1]}; }
__device__ __forceinline__ unsigned pk4_fp8(float a, float b, float c, float d) { int p = 0; p = __builtin_amdgcn_cvt_pk_fp8_f32(a, b, p, false); p = __builtin_amdgcn_cvt_pk_fp8_f32(c, d, p, true); return (unsigned)p; }
struct MapId { __device__ static int map(int n) { return n; } };
struct MapGlu { __device__ static int map(int n) { return ((n >> 7) & 1) * 1024 + (n >> 8) * 128 + (n & 127); } };
struct MapNsa { __device__ static int map(int n) { const int pn = n >> 8, bj = (n >> 7) & 1, j = n & 127, u = j >> 5, i = j & 31;
    if (pn < 4) return (4 * pn + u) * 64 + bj * 32 + i;
    if (pn == 4) return 1024 + (u < 2 ? 0 : 256) + (u & 1) * 64 + bj * 32 + i;
    if (pn == 5) return j < 64 ? 1536 + u * 64 + bj * 32 + i : 1152 + bj * 64 + (j - 64);
    if (pn == 6) return (bj ? 1664 : 1408) + j;
    return (bj == 0 && j < 48) ? 1792 + j : -1; } };
template <class MAP, bool FP8 = false> __device__ __forceinline__ void cvt_weights(const float* W, int ldw, int K, int N, bf16* WT, int nbatch, size_t sstride, size_t dstride, LAS unsigned char* lds, float scale = 1.0f) {
    const int lane = threadIdx.x & 63, wave = threadIdx.x >> 6;
    LAS float* scr = (LAS float*)(lds + wave * 16896);
    const int nkb = K / 64, nnb = N / 64; const long nitems = (long)nbatch * nkb * nnb;
    for (long it = (long)blockIdx.x * 8 + wave; it < nitems; it += (long)gridDim.x * 8) {
        const int nb = (int)(it % nnb); const long r = it / nnb; const int kb = (int)(r % nkb), z = (int)(r / nkb);
        const float* Wz = W + (size_t)z * sstride; bf16* WTz = FP8 ? (bf16*)((unsigned char*)WT + (size_t)z * dstride) : WT + (size_t)z * dstride;
        const int k0 = kb * 64, n0 = nb * 64, sc = MAP::map(n0 + lane);
        float wv[64];
        const float* wp = Wz + (size_t)k0 * ldw + (sc >= 0 ? sc : 0);
#pragma unroll
        for (int kk = 0; kk < 64; ++kk) wv[kk] = wp[(size_t)kk * ldw];
#pragma unroll
        for (int kk = 0; kk < 64; ++kk) scr[kk * 65 + lane] = sc >= 0 ? wv[kk] : 0.f;
        asm volatile("s_waitcnt lgkmcnt(0)" ::: "memory");
        const int c = lane & 7;
#pragma unroll
        for (int j = 0; j < 8; ++j) { const int n = (lane >> 3) + 8 * j; const LAS float* sp = scr + (8 * c) * 65 + n;
            if (FP8) { u32x2 o; o.x = pk4_fp8(sp[0] * scale, sp[65] * scale, sp[2 * 65] * scale, sp[3 * 65] * scale); o.y = pk4_fp8(sp[4 * 65] * scale, sp[5 * 65] * scale, sp[6 * 65] * scale, sp[7 * 65] * scale);
                *(u32x2*)((unsigned char*)WTz + (size_t)(n0 + n) * K + k0 + 8 * c) = o; }
            else { u32x4 o; o.x = cvt_pk_bf16(sp[0], sp[65]); o.y = cvt_pk_bf16(sp[2 * 65], sp[3 * 65]); o.z = cvt_pk_bf16(sp[4 * 65], sp[5 * 65]); o.w = cvt_pk_bf16(sp[6 * 65], sp[7 * 65]);
                *(u32x4*)(WTz + (size_t)(n0 + n) * K + k0 + 8 * c) = o; } }
        asm volatile("s_waitcnt lgkmcnt(0)" ::: "memory");
    }
}

template <class MAP> __device__ __forceinline__ void cvt_weights8(const float* W, int ldw, int K, int N, unsigned char* WT, int nbatch, size_t sstride, size_t dstride, LAS unsigned char* lds, float scale) {
    const int lane = threadIdx.x & 63, wave = threadIdx.x >> 6;
    LAS float* scr = (LAS float*)(lds + wave * 16896);
    const int nkb = K / 128, nnb = N / 32; const long nitems = (long)nbatch * nkb * nnb;
    for (long it = (long)blockIdx.x * 8 + wave; it < nitems; it += (long)gridDim.x * 8) {
        const int nb = (int)(it % nnb); const long r = it / nnb; const int kb = (int)(r % nkb), z = (int)(r / nkb);
        const float* Wz = W + (size_t)z * sstride; unsigned char* WTz = WT + (size_t)z * dstride;
        const int k0 = kb * 128, n0 = nb * 32, sc = MAP::map(n0 + (lane & 31)), kh = lane >> 5;
        float wv[64];
        const float* wp = Wz + (size_t)(k0 + kh) * ldw + (sc >= 0 ? sc : 0);
#pragma unroll
        for (int kk = 0; kk < 64; ++kk) wv[kk] = wp[(size_t)(2 * kk) * ldw];
#pragma unroll
        for (int kk = 0; kk < 64; ++kk) scr[(2 * kk + kh) * 33 + (lane & 31)] = sc >= 0 ? wv[kk] * scale : 0.f;
        asm volatile("s_waitcnt lgkmcnt(0)" ::: "memory");
        const int n = lane >> 1, half = lane & 1; const LAS float* sp = scr + (64 * half) * 33 + n;
        unsigned char* op = WTz + (size_t)(n0 + n) * K + k0 + 64 * half;
#pragma unroll
        for (int q = 0; q < 4; ++q) { u32x4 o;
            o.x = pk4_fp8(sp[(16 * q + 0) * 33], sp[(16 * q + 1) * 33], sp[(16 * q + 2) * 33], sp[(16 * q + 3) * 33]); o.y = pk4_fp8(sp[(16 * q + 4) * 33], sp[(16 * q + 5) * 33], sp[(16 * q + 6) * 33], sp[(16 * q + 7) * 33]);
            o.z = pk4_fp8(sp[(16 * q + 8) * 33], sp[(16 * q + 9) * 33], sp[(16 * q + 10) * 33], sp[(16 * q + 11) * 33]); o.w = pk4_fp8(sp[(16 * q + 12) * 33], sp[(16 * q + 13) * 33], sp[(16 * q + 14) * 33], sp[(16 * q + 15) * 33]);
            *(u32x4*)(op + 16 * q) = o; }
        asm volatile("s_waitcnt lgkmcnt(0)" ::: "memory");
    }
}
__device__ __forceinline__ void ph_convert_weights(const Ctx& C, LAS unsigned char* lds) {
    cvt_weights8<MapGlu>(C.f(I_MOE_W1), 2 * DFF, D_, 2 * DFF, C.w<unsigned char>(WS_W1T), DEPTH * NE, (size_t)D_ * 2 * DFF, (size_t)2 * DFF * D_, lds, W1_SCALE / KREP);
    cvt_weights8<MapId>(C.f(I_MOE_W2), D_, DFF, D_, C.w<unsigned char>(WS_W2T), DEPTH * NE, (size_t)DFF * D_, (size_t)D_ * DFF, lds, W2_SCALE / KREP);
    cvt_weights<MapId>(C.f(I_RET_W_IN), RW, D_, RW, C.w<bf16>(WS_RWIN), 1, 0, 0, lds);
    cvt_weights<MapId>(C.f(I_RET_W_OUT), D_, 2048, D_, C.w<bf16>(WS_RWOUT), 1, 0, 0, lds);
    cvt_weights<MapGlu>(C.f(I_CONV_W_PW1), 2 * D_, D_, 2 * D_, C.w<bf16>(WS_CPW1), 1, 0, 0, lds);
    cvt_weights<MapId>(C.f(I_CONV_W_PW2), D_, D_, D_, C.w<bf16>(WS_CPW2), 1, 0, 0, lds);
    cvt_weights<MapNsa>(C.f(I_NSA_W_IN), NINW, D_, 2048, C.w<bf16>(WS_NWIN), 1, 0, 0, lds);
    cvt_weights<MapId>(C.f(I_NSA_W_OUT), D_, D_, D_, C.w<bf16>(WS_NWOUT), 1, 0, 0, lds);
    cvt_weights<MapId>(C.f(I_NSA_K_W1), 256, 2048, 256, C.w<bf16>(WS_CW1T), 1, 0, 0, lds);
    cvt_weights<MapId>(C.f(I_NSA_V_W1), 256, 2048, 256, C.w<bf16>(WS_CW1T) + 256 * 2048, 1, 0, 0, lds);
    cvt_weights<MapId>(C.f(I_POOL_W), 256, 256, 256, C.w<bf16>(WS_PWT), 4, (size_t)256 * 256, (size_t)256 * 256, lds);
}


__device__ __forceinline__ u32x4 pg8_pack8(const f32x4& a, const f32x4& b) { u32x4 w; w.x = cvt_pk_bf16(a[0], a[1]); w.y = cvt_pk_bf16(a[2], a[3]); w.z = cvt_pk_bf16(b[0], b[1]); w.w = cvt_pk_bf16(b[2], b[3]); return w; }
template <int CTRL> __device__ __forceinline__ float dppf(float v) { return __builtin_bit_cast(float, __builtin_amdgcn_update_dpp(0, __builtin_bit_cast(int, v), CTRL, 0xf, 0xf, true)); }
template <int CTRL> __device__ __forceinline__ int dppi(int v) { return __builtin_amdgcn_update_dpp(0, v, CTRL, 0xf, 0xf, true); }
constexpr int DPP_X1 = 0xB1, DPP_X2 = 0x4E, DPP_HM = 0x141, DPP_RM = 0x140;
__device__ __forceinline__ float row16_max(float v) { v = fmaxf(v, dppf<DPP_X1>(v)); v = fmaxf(v, dppf<DPP_X2>(v)); v = fmaxf(v, dppf<DPP_HM>(v)); return fmaxf(v, dppf<DPP_RM>(v)); }
__device__ __forceinline__ int row16_min(int v) { int o = dppi<DPP_X1>(v); v = o < v ? o : v; o = dppi<DPP_X2>(v); v = o < v ? o : v; o = dppi<DPP_HM>(v); v = o < v ? o : v; o = dppi<DPP_RM>(v); return o < v ? o : v; }
__device__ __forceinline__ float wave_sum(float v) {
    v += dppf<DPP_X1>(v); v += dppf<DPP_X2>(v); v += dppf<DPP_HM>(v); v += dppf<DPP_RM>(v);
    { const unsigned u = __builtin_bit_cast(unsigned, v); const auto r = __builtin_amdgcn_permlane16_swap(u, u, false, false); v = bits_f32(r[0]) + bits_f32(r[1]); }
    { const unsigned u = __builtin_bit_cast(unsigned, v); const auto r = __builtin_amdgcn_permlane32_swap(u, u, false, false); v = bits_f32(r[0]) + bits_f32(r[1]); }
    return v;
}
template <int WHICH, bool DRY = false, bool XIN32 = false, bool XOUT32 = false> __device__ __forceinline__ void ln_fast(const Ctx& C, const int l, LAS unsigned char* lds) {
    float* const xout = DRY ? C.w<float>(WS_MX) : C.out; bf16* const xb = C.w<bf16>(WS_XB); bf16* const hout = DRY ? C.w<bf16>(WS_MX) + (size_t)T_ * D_ * 2 : C.w<bf16>(WS_H);
    int tid_ = threadIdx.x; asm volatile("" : "+v"(tid_)); const int tid = tid_, lane = tid & 63, wave = tid >> 6;
    const float* xsrc = C.f(I_X);
    const bool has_next = WHICH == 0 || l + 1 < DEPTH; const int nl = WHICH ? l + 1 : l;
    LAS bf16* rwT = (LAS bf16*)lds;
    LAS int* tbase = (LAS int*)(lds + 69632);
    LAS int* lhist = (LAS int*)(lds + 70144); LAS int* lbase = lhist + 32;
    LAS int* wcnt = lbase + 32;
    LAS bf16* hs = (LAS bf16*)(lds + 70656 + wave * 8256);
    LAS u32x2* wl = (LAS u32x2*)(lds + 136704 + wave * 512);
    if (WHICH == 0 && tid < 32) lhist[tid] = 0;
    if (WHICH == 0 && tid < 8) wcnt[tid] = 0;
    if (WHICH == 0) { const float* rw = C.f(I_ROUTER_W) + (size_t)l * D_ * NE;
        for (int i = tid; i < D_ * NE; i += NTHREADS) { const int k = i >> 5, e = i & 31; rwT[e * 1032 + k] = f2bf(rw[i]); } }
    if (WHICH == 1) { if (tid == 0) { int a = 0; for (int e = 0; e < NE; ++e) { tbase[e] = a; a += (C.cnt(l)[e] + 255) >> 8; } } }
    __syncthreads();
    f32x4 gtv[4], shv[4], scv[4];
    const float* lgp = C.f(WHICH ? I_LN2_G : I_LN1_G) + l * D_ + 4 * lane; const float* lbp = C.f(WHICH ? I_LN2_B : I_LN1_B) + l * D_ + 4 * lane;
    f32x4 lgv[4], lbv[4];
#pragma unroll
    for (int j = 0; j < 4; ++j) { lgv[j] = *(const f32x4*)(lgp + 256 * j); lbv[j] = *(const f32x4*)(lbp + 256 * j); }
    const int nchunk = T_ / 16;
    for (int chunk = blockIdx.x * 8 + wave; chunk < nchunk; chunk += gridDim.x * 8) {
        const size_t row0 = (size_t)chunk * 16; const int b = (int)(row0 / S_);
        { const float* gt = C.mod(l, b, WHICH ? 5 : 2);
#pragma unroll
          for (int j = 0; j < 4; ++j) { gtv[j] = *(const f32x4*)(gt + 4 * lane + 256 * j);
              if (has_next) { shv[j] = *(const f32x4*)(C.mod(nl, b, WHICH ? 0 : 3) + 4 * lane + 256 * j); scv[j] = *(const f32x4*)(C.mod(nl, b, WHICH ? 1 : 4) + 4 * lane + 256 * j); } } }
        constexpr int RPI = WHICH == 0 ? 4 : 2;
        int4 epv = {0, 0, 0, 0}; float twv_x = 0.f, twv_y = 0.f, twv_z = 0.f, twv_w = 0.f;
        if (WHICH == 1) { const size_t tl = row0 + (lane & 15); epv = *(const int4*)(C.w<int>(WS_EP) + tl * 4); const f32x4 twv = *(const f32x4*)(C.w<float>(WS_TOPW) + tl * 4); twv_x = twv[0]; twv_y = twv[1]; twv_z = twv[2]; twv_w = twv[3]; }
        constexpr bool PREF = WHICH == 1;
        u32x2 rx[RPI][4]; f32x4 rxf[RPI][4]; u32x2 ry[RPI][4]; int rq[RPI][4][4]; f32x4 rtw[RPI];
        auto issue = [&](const int rp) {
#pragma unroll
            for (int rr = 0; rr < RPI; ++rr) {
                const size_t t = row0 + rp + rr;
#pragma unroll
                for (int j = 0; j < 4; ++j) { if constexpr (XIN32) rxf[rr][j] = *(const f32x4*)(xsrc + t * D_ + 4 * lane + 256 * j); else rx[rr][j] = *(const u32x2*)(xb + t * D_ + 4 * lane + 256 * j); }
                if (WHICH == 0) {
#pragma unroll
                    for (int j = 0; j < 4; ++j) ry[rr][j] = *(const u32x2*)(C.w<bf16>(WS_Y) + t * D_ + 4 * lane + 256 * j);
                } else {
                    const int rsel = rp + rr; f32x4 tw; int4 ep;
                    tw[0] = bits_f32((unsigned)__builtin_amdgcn_readlane((int)__builtin_bit_cast(unsigned, twv_x), rsel)); tw[1] = bits_f32((unsigned)__builtin_amdgcn_readlane((int)__builtin_bit_cast(unsigned, twv_y), rsel));
                    tw[2] = bits_f32((unsigned)__builtin_amdgcn_readlane((int)__builtin_bit_cast(unsigned, twv_z), rsel)); tw[3] = bits_f32((unsigned)__builtin_amdgcn_readlane((int)__builtin_bit_cast(unsigned, twv_w), rsel));
                    ep.x = __builtin_amdgcn_readlane(epv.x, rsel); ep.y = __builtin_amdgcn_readlane(epv.y, rsel); ep.z = __builtin_amdgcn_readlane(epv.z, rsel); ep.w = __builtin_amdgcn_readlane(epv.w, rsel);
                    const size_t y0 = (size_t)tbase[ep.x >> 20] * 256 + (ep.x & 0xfffff), y1 = (size_t)tbase[ep.y >> 20] * 256 + (ep.y & 0xfffff), y2 = (size_t)tbase[ep.z >> 20] * 256 + (ep.z & 0xfffff), y3 = (size_t)tbase[ep.w >> 20] * 256 + (ep.w & 0xfffff);
                    const unsigned char* YC = C.w<unsigned char>(WS_YC); rtw[rr] = tw * (1.0f / YC_SCALE);
#pragma unroll
                    for (int j = 0; j < 4; ++j) { rq[rr][j][0] = *(const int*)(YC + y0 * D_ + 4 * lane + 256 * j); rq[rr][j][1] = *(const int*)(YC + y1 * D_ + 4 * lane + 256 * j);
                        rq[rr][j][2] = *(const int*)(YC + y2 * D_ + 4 * lane + 256 * j); rq[rr][j][3] = *(const int*)(YC + y3 * D_ + 4 * lane + 256 * j); }
                }
            } };
        if constexpr (PREF) issue(0);
#pragma unroll 1
        for (int rp = 0; rp < 16; rp += RPI) {
            f32x4 v[RPI][4];
            if constexpr (!PREF) issue(rp);
#pragma unroll
            for (int rr = 0; rr < RPI; ++rr) {
#pragma unroll
                for (int j = 0; j < 4; ++j) { f32x4 xv; if constexpr (XIN32) xv = rxf[rr][j]; else { const u32x2 px = rx[rr][j]; xv = (f32x4){bits_f32(px.x << 16), bits_f32(px.x & 0xffff0000u), bits_f32(px.y << 16), bits_f32(px.y & 0xffff0000u)}; }
                    f32x4 yv;
                    if (WHICH == 0) { const u32x2 p = ry[rr][j]; yv = (f32x4){bits_f32(p.x << 16), bits_f32(p.x & 0xffff0000u), bits_f32(p.y << 16), bits_f32(p.y & 0xffff0000u)}; }
                    else { yv = fp8x4(rq[rr][j][0]) * rtw[rr][0]; yv += fp8x4(rq[rr][j][1]) * rtw[rr][1]; yv += fp8x4(rq[rr][j][2]) * rtw[rr][2]; yv += fp8x4(rq[rr][j][3]) * rtw[rr][3]; }
                    v[rr][j] = xv * DN_ALPHA + (gtv[j] + 1.0f) * yv; }
            }
            if constexpr (PREF) { if (rp + RPI < 16) issue(rp + RPI); }
#pragma unroll
            for (int rr = 0; rr < RPI; ++rr) {
                const size_t t = row0 + rp + rr;
                float sm = 0.f;
#pragma unroll
                for (int j = 0; j < 4; ++j) sm += (v[rr][j][0] + v[rr][j][1]) + (v[rr][j][2] + v[rr][j][3]);
                const float mu = wave_sum(sm) * (1.0f / D_); float q = 0.f;
#pragma unroll
                for (int j = 0; j < 4; ++j) { v[rr][j] = v[rr][j] - mu; q += (v[rr][j][0] * v[rr][j][0] + v[rr][j][1] * v[rr][j][1]) + (v[rr][j][2] * v[rr][j][2] + v[rr][j][3] * v[rr][j][3]); }
                const float rstd = __builtin_amdgcn_rsqf(wave_sum(q) * (1.0f / D_) + LN_EPS);
#pragma unroll
                for (int j = 0; j < 4; ++j) { const f32x4 xn = v[rr][j] * rstd * lgv[j] + lbv[j];
                    if constexpr (XOUT32 || DRY) *(f32x4*)(xout + t * D_ + 4 * lane + 256 * j) = xn; else { u32x2 px; px.x = cvt_pk_bf16(xn[0], xn[1]); px.y = cvt_pk_bf16(xn[2], xn[3]); *(u32x2*)(xb + t * D_ + 4 * lane + 256 * j) = px; }
                    if (has_next) { const f32x4 h = xn * (scv[j] + 1.0f) + shv[j]; u32x2 p; p.x = cvt_pk_bf16(h[0], h[1]); p.y = cvt_pk_bf16(h[2], h[3]);
                        if (WHICH == 0) { *(LAS u32x2*)(hs + ((rp + rr) & 3) * 1032 + 4 * lane + 256 * j) = p;
                            if (!DRY) *(unsigned*)(C.w<unsigned char>(WS_H8) + t * D_ + 4 * lane + 256 * j) = pk4_fp8(h[0], h[1], h[2], h[3]); }
                        else *(u32x2*)(hout + t * D_ + 4 * lane + 256 * j) = p; } }
            }
                    if (WHICH == 0) {
                asm volatile("s_waitcnt lgkmcnt(0)" ::: "memory");
                const int r16 = lane & 15, kg = lane >> 4;
                f32x4 pa[2] = {(f32x4){0.f, 0.f, 0.f, 0.f}, (f32x4){0.f, 0.f, 0.f, 0.f}};
#pragma unroll 8
                for (int sx = 0; sx < 32; ++sx) { const bf16x8 a = *(const LAS bf16x8*)(hs + (r16 & 3) * 1032 + 32 * sx + 8 * kg);
                    const bf16x8 b0 = *(const LAS bf16x8*)(rwT + r16 * 1032 + 32 * sx + 8 * kg), b1 = *(const LAS bf16x8*)(rwT + (16 + r16) * 1032 + 32 * sx + 8 * kg);
                    pa[0] = __builtin_amdgcn_mfma_f32_16x16x32_bf16(a, b0, pa[0], 0, 0, 0); pa[1] = __builtin_amdgcn_mfma_f32_16x16x32_bf16(a, b1, pa[1], 0, 0, 0); }
                const float rb0 = C.f(I_ROUTER_B)[l * NE + r16], rb1 = C.f(I_ROUTER_B)[l * NE + 16 + r16];
#pragma unroll
                for (int i = 0; i < 4; ++i) {
                    float l0 = pa[0][i] + rb0, l1 = pa[1][i] + rb1; float tv[4]; int rk0 = -1, rk1 = -1;
#pragma unroll
                    for (int kk = 0; kk < 4; ++kk) {
                        float mx = fmaxf(l0, l1);
                        mx = row16_max(mx);
                        int idx = (l0 == mx) ? r16 : ((l1 == mx) ? 16 + r16 : 64);
                        idx = row16_min(idx);
                        tv[kk] = mx; if (idx == r16) { rk0 = kk; l0 = -3.3e38f; } else if (idx == 16 + r16) { rk1 = kk; l1 = -3.3e38f; }
                    }
                    const float e1 = __builtin_amdgcn_exp2f((tv[1] - tv[0]) * 1.4426950408889634f), e2 = __builtin_amdgcn_exp2f((tv[2] - tv[0]) * 1.4426950408889634f), e3 = __builtin_amdgcn_exp2f((tv[3] - tv[0]) * 1.4426950408889634f); const float inv = __builtin_amdgcn_rcpf(1.0f + e1 + e2 + e3);
                    const size_t t = row0 + rp + i;
                    if (!DRY && kg == 0 && rk0 >= 0) { C.w<float>(WS_TOPW)[t * 4 + rk0] = (rk0 == 0 ? 1.0f : rk0 == 1 ? e1 : rk0 == 2 ? e2 : e3) * inv;
                        const int lp = __hip_atomic_fetch_add(lhist + r16, 1, __ATOMIC_RELAXED, __HIP_MEMORY_SCOPE_WORKGROUP), ps = __hip_atomic_fetch_add(wcnt + wave, 1, __ATOMIC_RELAXED, __HIP_MEMORY_SCOPE_WORKGROUP);
                        wl[ps] = (u32x2){(unsigned)t, (unsigned)(r16 | (rk0 << 8) | (lp << 16))}; }
                    if (!DRY && kg == 0 && rk1 >= 0) { C.w<float>(WS_TOPW)[t * 4 + rk1] = (rk1 == 0 ? 1.0f : rk1 == 1 ? e1 : rk1 == 2 ? e2 : e3) * inv;
                        const int lp = __hip_atomic_fetch_add(lhist + 16 + r16, 1, __ATOMIC_RELAXED, __HIP_MEMORY_SCOPE_WORKGROUP), ps = __hip_atomic_fetch_add(wcnt + wave, 1, __ATOMIC_RELAXED, __HIP_MEMORY_SCOPE_WORKGROUP);
                        wl[ps] = (u32x2){(unsigned)t, (unsigned)((16 + r16) | (rk1 << 8) | (lp << 16))}; }
                }
            }
        }
        if (WHICH == 0) {
            __syncthreads();
            if (tid < 32) lbase[tid] = atomicAdd(C.cnt(l) + tid, lhist[tid]);
            __syncthreads();
            if (!DRY && lane < wcnt[wave]) { const u32x2 en = wl[lane]; const int e = en.y & 0xff, rk = (en.y >> 8) & 0xff, p = lbase[e] + (int)(en.y >> 16);
                C.w<int>(WS_LIST)[(size_t)e * T_ + p] = (int)en.x; C.w<int>(WS_EP)[(size_t)en.x * 4 + rk] = (e << 20) | p; }
        }
    }
}

typedef float f32x16 __attribute__((ext_vector_type(16)));
typedef __bf16 bf16x2_t __attribute__((ext_vector_type(2)));
typedef float f32x2_t __attribute__((ext_vector_type(2)));
__device__ __forceinline__ unsigned cvtpk(float lo, float hi) { const f32x2_t v = {lo, hi}; const bf16x2_t b = __builtin_convertvector(v, bf16x2_t); return __builtin_bit_cast(unsigned, b); }
__device__ __forceinline__ int crow32(int i, int h) { return (i & 3) + 8 * (i >> 2) + 4 * h; }
constexpr float NSA_NEG = -1.0e30f, L2E = 1.4426950408889634f;
constexpr int KT_ELEMS = 64 * 72, VT_LD = 96, VT_ELEMS = 64 * VT_LD;
struct KVRegs { u32x4 k, v; };
__device__ __forceinline__ void kv_load(KVRegs& r, const bf16* K, const bf16* V, int stride, int tid) {
    r.k = *(const u32x4*)(K + (size_t)(tid >> 3) * stride + 8 * (tid & 7)); r.v = *(const u32x4*)(V + (size_t)(tid >> 3) * stride + 8 * (tid & 7)); }
__device__ __forceinline__ void kv_store(const KVRegs& r, LAS bf16* Ks, LAS bf16* Vt, int tid) {
    const int key = tid >> 3, ch = tid & 7;
    *(LAS u32x4*)(Ks + key * 72 + 8 * ch) = r.k;
    *(LAS u32x4*)(Vt + key * VT_LD + 8 * ch) = r.v;
}
template <int B> __device__ __forceinline__ void tr8(u32x2 (&a)[8], unsigned vb) {
    asm volatile("ds_read_b64_tr_b16 %0, %8 offset:%9\n\tds_read_b64_tr_b16 %1, %8 offset:%10\n\tds_read_b64_tr_b16 %2, %8 offset:%11\n\tds_read_b64_tr_b16 %3, %8 offset:%12\n\t"
                 "ds_read_b64_tr_b16 %4, %8 offset:%13\n\tds_read_b64_tr_b16 %5, %8 offset:%14\n\tds_read_b64_tr_b16 %6, %8 offset:%15\n\tds_read_b64_tr_b16 %7, %8 offset:%16"
                 : "=&v"(a[0]), "=&v"(a[1]), "=&v"(a[2]), "=&v"(a[3]), "=&v"(a[4]), "=&v"(a[5]), "=&v"(a[6]), "=&v"(a[7])
                 : "v"(vb), "i"(B + 0), "i"(B + 8 * VT_LD * 2), "i"(B + 64), "i"(B + 8 * VT_LD * 2 + 64), "i"(B + 16 * VT_LD * 2), "i"(B + 24 * VT_LD * 2), "i"(B + 16 * VT_LD * 2 + 64), "i"(B + 24 * VT_LD * 2 + 64) : "memory");
}
__device__ __forceinline__ void tr_wait(u32x2 (&a)[8]) {
    asm volatile("s_waitcnt lgkmcnt(0)" : "+v"(a[0]), "+v"(a[1]), "+v"(a[2]), "+v"(a[3]), "+v"(a[4]), "+v"(a[5]), "+v"(a[6]), "+v"(a[7]) :: "memory"); }
__device__ __forceinline__ void qk_tile(const LAS bf16* Ks, const bf16x8 (&qf)[4], f32x16& S0, f32x16& S1, int c, int h, float init) {
#pragma unroll
    for (int i = 0; i < 16; ++i) { S0[i] = init; S1[i] = init; }
#pragma unroll
    for (int sx = 0; sx < 4; ++sx) { const bf16x8 a0 = *(const LAS bf16x8*)(Ks + c * 72 + 16 * sx + 8 * h), a1 = *(const LAS bf16x8*)(Ks + (32 + c) * 72 + 16 * sx + 8 * h);
        S0 = __builtin_amdgcn_mfma_f32_32x32x16_bf16(a0, qf[sx], S0, 0, 0, 0); S1 = __builtin_amdgcn_mfma_f32_32x32x16_bf16(a1, qf[sx], S1, 0, 0, 0); }
}
constexpr float NSA_MASK = -2.0e30f, NSA_THR = 12.0f;
template <int MODE> __device__ __forceinline__ bool key_ok(int key, int s) {
    if (MODE == 0) return 16 * key + 31 <= s; if (MODE == 1) return key <= s; return key <= s && key > s - NWIN; }
template <int MODE> __device__ __forceinline__ void attn_tile(const LAS bf16* Ks, const LAS bf16* Vt, const bf16x8 (&qf)[4], f32x16 (&O)[2], float& m, float& l, int kbase, int s, bool on, bool masked, int c, int h) {
    const bool mset = m > -1.0e29f; const float mref = mset ? m : 0.f;
    f32x16 S0, S1; qk_tile(Ks, qf, S0, S1, c, h, on ? -mref : NSA_MASK);
    u32x2 va[8], vb8[8];
    { const int lane = c + 32 * h; const unsigned vbase = (unsigned)(unsigned long)Vt + (unsigned)((4 * (lane >> 5) + ((lane >> 2) & 3)) * (VT_LD * 2) + (16 * ((lane >> 4) & 1) + 4 * (lane & 3)) * 2);
      tr8<0>(va, vbase); tr8<32 * VT_LD * 2>(vb8, vbase); }
    if (masked) {
#pragma unroll
        for (int i = 0; i < 16; ++i) { const int k0 = kbase + crow32(i, h); S0[i] = key_ok<MODE>(k0, s) ? S0[i] : NSA_MASK; S1[i] = key_ok<MODE>(k0 + 32, s) ? S1[i] : NSA_MASK; } }
    float mx = NSA_MASK;
#pragma unroll
    for (int i = 0; i < 16; ++i) mx = __builtin_fmaxf(__builtin_fmaxf(mx, S0[i]), S1[i]);
    { const unsigned u = __builtin_bit_cast(unsigned, mx); const auto r = __builtin_amdgcn_permlane32_swap(u, u, false, false); mx = fmaxf(bits_f32(r[0]), bits_f32(r[1])); }
    const bool fix = mset ? (mx > NSA_THR) : (mx > -1.0e29f);
    if (__any(fix)) {
        const float delta = fix ? mx : 0.f, alpha = (fix && mset) ? __builtin_amdgcn_exp2f(-delta) : 1.0f;
#pragma unroll
        for (int i = 0; i < 16; ++i) { S0[i] -= delta; S1[i] -= delta; O[0][i] *= alpha; O[1][i] *= alpha; }
        l *= alpha; if (fix) m = mref + delta;
    }
    float ps = 0.f;
#pragma unroll
    for (int i = 0; i < 16; ++i) { S0[i] = __builtin_amdgcn_exp2f(S0[i]); S1[i] = __builtin_amdgcn_exp2f(S1[i]); ps += S0[i] + S1[i]; }
    l += ps;
    tr_wait(va); tr_wait(vb8);
#pragma unroll
    for (int blk = 0; blk < 2; ++blk)
#pragma unroll
        for (int s2 = 0; s2 < 2; ++s2) { const f32x16& P = blk ? S1 : S0; u32x4 pw;
            pw.x = cvt_pk_bf16(P[8 * s2 + 0], P[8 * s2 + 1]); pw.y = cvt_pk_bf16(P[8 * s2 + 2], P[8 * s2 + 3]); pw.z = cvt_pk_bf16(P[8 * s2 + 4], P[8 * s2 + 5]); pw.w = cvt_pk_bf16(P[8 * s2 + 6], P[8 * s2 + 7]);
            const bf16x8 pf = __builtin_bit_cast(bf16x8, pw);
#pragma unroll
            for (int db = 0; db < 2; ++db) { const u32x2 t0 = blk ? vb8[2 * (2 * s2 + db)] : va[2 * (2 * s2 + db)], t1 = blk ? vb8[2 * (2 * s2 + db) + 1] : va[2 * (2 * s2 + db) + 1];
                const u32x4 aw = {t0.x, t0.y, t1.x, t1.y};
                O[db] = __builtin_amdgcn_mfma_f32_32x32x16_bf16(__builtin_bit_cast(bf16x8, aw), pf, O[db], 0, 0, 0); } }
}
template <int MODE> __device__ __forceinline__ void attn_branch(const bf16* K0, const bf16* V0, int stride, int j0, int j1, int jm0, int jm1, LAS bf16* KsB, LAS bf16* VtB, const bf16x8 (&qf)[4],
                                                                 f32x16 (&O)[2], float& m, float& l, int s, u64 sel, int tid, int c, int h) {
    KVRegs r;
    if (j0 < j1) { kv_load(r, K0 + (size_t)j0 * 64 * stride, V0 + (size_t)j0 * 64 * stride, stride, tid); kv_store(r, KsB, VtB, tid); }
    if (j0 + 1 < j1) kv_load(r, K0 + (size_t)(j0 + 1) * 64 * stride, V0 + (size_t)(j0 + 1) * 64 * stride, stride, tid);
    __syncthreads();
    for (int j = j0; j < j1; ++j) {
        const int buf = (j - j0) & 1; const bool on = MODE == 1 ? (bool)((sel >> j) & 1ull) : true;
        if (MODE != 1 || __any(on))
            attn_tile<MODE>(KsB + buf * KT_ELEMS, VtB + buf * VT_ELEMS, qf, O, m, l, 64 * j, s, on, !(j >= jm0 && j < jm1), c, h);
        if (j + 1 < j1) { kv_store(r, KsB + (buf ^ 1) * KT_ELEMS, VtB + (buf ^ 1) * VT_ELEMS, tid);
            if (j + 2 < j1) kv_load(r, K0 + (size_t)(j + 2) * 64 * stride, V0 + (size_t)(j + 2) * 64 * stride, stride, tid); }
        __syncthreads();
    }
}
__device__ __forceinline__ void nsa_attn_fast(const Ctx& C, LAS unsigned char* lds) {
    int tid_ = threadIdx.x; asm volatile("" : "+v"(tid_)); const int tid = tid_, lane = tid & 63, wave = tid >> 6, c = lane & 31, h = lane >> 5;
    LAS bf16* KsB = (LAS bf16*)lds; LAS bf16* VtB = KsB + 2 * KT_ELEMS;
    LAS float* imp = (LAS float*)(lds + 2 * KT_ELEMS * 2 + 2 * VT_ELEMS * 2);
    LAS float* scr = imp + 32 * 64;
    const bf16* NQp = C.w<bf16>(WS_NQ); const bf16* KV = C.w<bf16>(WS_NKV); const bf16* CKV = C.w<bf16>(WS_CMPKV); const float* GT = C.w<float>(WS_NGT); bf16* NO = C.w<bf16>(WS_NO);
    const int nunits = NBG * (S_ / 32);
    const bool mirror = (gridDim.x % NBG) == 0 && ((S_ / 32) % (2 * (gridDim.x / NBG))) == 0; const int nr = gridDim.x / NBG;
    int round_ = 0;
    for (int unit0 = blockIdx.x; unit0 < nunits; unit0 += gridDim.x, ++round_) {
        int unit = unit0;
        if (mirror && (round_ & 1)) { const int r = blockIdx.x / NBG; unit = (blockIdx.x % NBG) + NBG * ((nr - 1 - r) + nr * round_); }
        const int bg = unit % NBG, tile = unit / NBG, b = bg / NG, g = bg % NG, s0 = tile * 32;
        const int s = s0 + wave * 4 + (c >> 3), hd = g * NR + (c & 7), cur = s0 >> 6; const size_t tb = (size_t)b * S_, t = tb + s;
        bf16x8 qf[4];
#pragma unroll
        for (int sx = 0; sx < 4; ++sx) qf[sx] = *(const bf16x8*)(NQp + t * D_ + hd * 64 + 16 * sx + 8 * h);
        f32x16 out[2], O[2];
#pragma unroll
        for (int i = 0; i < 16; ++i) { out[0][i] = 0.f; out[1][i] = 0.f; O[0][i] = 0.f; O[1][i] = 0.f; }
        for (int i = tid; i < 32 * 64; i += NTHREADS) imp[i] = 0.f;
        const bf16* Kc = CKV + (size_t)(b * NG + g) * 256 * 64; const bf16* Vc = CKV + (size_t)(NBG + b * NG + g) * 256 * 64;
        const int smax = s0 + 31, nvmax = smax >= 31 ? (smax - 31) / 16 + 1 : 0, nct = (nvmax + 63) / 64;
        float m = NSA_NEG, l = 0.f;
        attn_branch<0>(Kc, Vc, 64, 0, nct, 0, 0, KsB, VtB, qf, O, m, l, s, 0ull, tid, c, h);
        { const float lt = l + __shfl_xor(l, 32); const float sc = lt > 0.f ? GT[t * 48 + (hd) * 3 + 0] / lt : 0.f;
#pragma unroll
          for (int i = 0; i < 16; ++i) { out[0][i] += O[0][i] * sc; out[1][i] += O[1][i] * sc; O[0][i] = 0.f; O[1][i] = 0.f; }
          const float linv = lt > 0.f ? 1.0f / lt : 0.f;
          for (int j = 0; j < nct; ++j) {
              KVRegs r; kv_load(r, Kc + (size_t)j * 64 * 64, Vc + (size_t)j * 64 * 64, 64, tid); kv_store(r, KsB, VtB, tid);
              __syncthreads();
              f32x16 S0, S1; qk_tile(KsB, qf, S0, S1, c, h, 0.f);
#pragma unroll
              for (int blk = 0; blk < 2; ++blk)
#pragma unroll
                  for (int q4 = 0; q4 < 4; ++q4) { float s4 = 0.f, last = 0.f; const int n0 = 64 * j + 32 * blk + 8 * q4 + 4 * h;
#pragma unroll
                      for (int e = 0; e < 4; ++e) { const float sv = (blk ? S1 : S0)[4 * q4 + e]; const float p = (16 * (n0 + e) + 31 <= s) ? __builtin_amdgcn_exp2f(sv - m) * linv : 0.f; s4 += p; last = p; }
                      s4 += __shfl_xor(s4, 1); last += __shfl_xor(last, 1); s4 += __shfl_xor(s4, 2); last += __shfl_xor(last, 2); s4 += __shfl_xor(s4, 4); last += __shfl_xor(last, 4);
                      if ((c & 7) == 0) { LAS float* ip = imp + (wave * 4 + (c >> 3)) * 64 + (n0 >> 2);
                          __hip_atomic_fetch_add(ip, s4, __ATOMIC_RELAXED, __HIP_MEMORY_SCOPE_WORKGROUP);
                          if ((n0 >> 2) + 1 < 64) __hip_atomic_fetch_add(ip + 1, last, __ATOMIC_RELAXED, __HIP_MEMORY_SCOPE_WORKGROUP); } }
              __syncthreads();
          } }
        u64 mysel = 0ull;
#pragma unroll 1
        for (int tk = 0; tk < 4; ++tk) {
            const int j = lane; float sc = imp[(wave * 4 + tk) * 64 + j];
            sc = j > cur ? -3.0e38f : ((j == 0 || j == cur || j == cur - 1) ? 1.0e6f : sc);
            scr[wave * 64 + j] = sc;
            asm volatile("s_waitcnt lgkmcnt(0)" ::: "memory");
            int rank = 0;
#pragma unroll 4
            for (int jj = 0; jj <= cur; ++jj) { const float o = scr[wave * 64 + jj]; rank += (o > sc || (o == sc && jj < j)) ? 1 : 0; }
            const u64 bal = __ballot(j <= cur && rank < KSEL);
            if ((c >> 3) == tk) mysel = bal;
            asm volatile("s_waitcnt lgkmcnt(0)" ::: "memory");
        }
        m = NSA_NEG; l = 0.f;
        attn_branch<1>(KV + tb * NKVW + 256 + g * 64, KV + tb * NKVW + 384 + g * 64, NKVW, 0, cur + 1, 0, cur, KsB, VtB, qf, O, m, l, s, mysel, tid, c, h);
        { const float lt = l + __shfl_xor(l, 32); const float sc = lt > 0.f ? GT[t * 48 + hd * 3 + 1] / lt : 0.f;
#pragma unroll
          for (int i = 0; i < 16; ++i) { out[0][i] += O[0][i] * sc; out[1][i] += O[1][i] * sc; O[0][i] = 0.f; O[1][i] = 0.f; } }
        m = NSA_NEG; l = 0.f;
        { const int lo = s0 - (NWIN - 1); const int jlo = lo > 0 ? lo >> 6 : 0;
          const int jin = (s0 - 480 + 63) >> 6;
          attn_branch<2>(KV + tb * NKVW + 512 + g * 64, KV + tb * NKVW + 640 + g * 64, NKVW, jlo, cur + 1, jin > jlo ? jin : jlo, cur, KsB, VtB, qf, O, m, l, s, 0ull, tid, c, h); }
        { const float lt = l + __shfl_xor(l, 32); const float sc = lt > 0.f ? GT[t * 48 + hd * 3 + 2] / lt : 0.f;
#pragma unroll
          for (int db = 0; db < 2; ++db)
#pragma unroll
              for (int k2 = 0; k2 < 2; ++k2) { u32x2 w[2];
#pragma unroll
                  for (int qq = 0; qq < 2; ++qq) { const int q4 = 2 * k2 + qq; w[qq].x = cvtpk(out[db][4 * q4 + 0] + O[db][4 * q4 + 0] * sc, out[db][4 * q4 + 1] + O[db][4 * q4 + 1] * sc);
                      w[qq].y = cvtpk(out[db][4 * q4 + 2] + O[db][4 * q4 + 2] * sc, out[db][4 * q4 + 3] + O[db][4 * q4 + 3] * sc); }
                  const auto rx = __builtin_amdgcn_permlane32_swap(w[0].x, w[1].x, false, false), ry = __builtin_amdgcn_permlane32_swap(w[0].y, w[1].y, false, false);
                  *(u32x4*)(NO + t * D_ + hd * 64 + 32 * db + 16 * k2 + 8 * h) = (u32x4){rx[0], ry[0], rx[1], ry[1]}; } }
        __syncthreads();
    }
}


__device__ __forceinline__ f32x2_t bf2x(unsigned p) { return (f32x2_t){bits_f32(p << 16), bits_f32(p & 0xffff0000u)}; }
__device__ __forceinline__ void mod_fast(const Ctx& C, LAS unsigned char* lds) {
    int tid_ = threadIdx.x; asm volatile("" : "+v"(tid_)); const int tid = tid_, lane = tid & 63, wave = tid >> 6;
    LAS float* sc = (LAS float*)lds;
    LAS float* red = sc + NB * D_;
    for (int i = tid; i < NB * D_; i += NTHREADS) sc[i] = siluf_(C.f(I_C)[i]);
    __syncthreads();
    const int nitems = DEPTH * (6 * D_ / 128);
    for (int it = blockIdx.x; it < nitems; it += gridDim.x) {
        const int l = it / (6 * D_ / 128), j0 = (it % (6 * D_ / 128)) * 128;
        const float* W = C.f(I_ADA_W) + (size_t)l * D_ * 6 * D_ + j0 + 2 * lane;
        f32x2_t acc[NB];
#pragma unroll
        for (int b = 0; b < NB; ++b) acc[b] = (f32x2_t){0.f, 0.f};
#pragma unroll 8
        for (int kk = 0; kk < 128; ++kk) { const int k = wave * 128 + kk; const f32x2_t w = *(const f32x2_t*)(W + (size_t)k * 6 * D_);
#pragma unroll
            for (int b = 0; b < NB; ++b) acc[b] += w * sc[b * D_ + k]; }
#pragma unroll
        for (int b = 0; b < NB; ++b) *(LAS f32x2_t*)(red + (wave * NB + b) * 128 + 2 * lane) = acc[b];
        __syncthreads();
        for (int o = tid; o < NB * 128; o += NTHREADS) { const int b = o >> 7, j = o & 127; float a = C.f(I_ADA_B)[l * 6 * D_ + j0 + j];
#pragma unroll
            for (int w = 0; w < 8; ++w) a += red[(w * NB + b) * 128 + j];
            C.w<float>(WS_MOD)[(size_t)(l * NB + b) * 6 * D_ + j0 + j] = a; }
        __syncthreads();
    }
}
__device__ __forceinline__ void cb_fast(const Ctx& C, LAS unsigned char* lds) {
    int tid_ = threadIdx.x; asm volatile("" : "+v"(tid_)); const int tid = tid_, j = tid & 31, ig = tid >> 5; LAS float* red = (LAS float*)lds;
    for (int it = (int)gridDim.x - 1 - (int)blockIdx.x; it < 16; it += gridDim.x) {
        const int tz = it >> 3, j0 = (it & 7) * 32;
        const float* pe = C.f(tz ? I_NSA_POS_V : I_NSA_POS_K) + ig * 128; const float* w1 = C.f(tz ? I_NSA_V_W1 : I_NSA_K_W1) + (size_t)ig * 128 * 256 + j0 + j;
        float a = 0.f;
#pragma unroll 8
        for (int i = 0; i < 128; ++i) a += pe[i] * w1[(size_t)i * 256];
        red[ig * 32 + j] = a;
        __syncthreads();
        if (tid < 32) { float t = 0.f;
#pragma unroll
            for (int g = 0; g < 16; ++g) t += red[g * 32 + tid];
            C.w<float>(WS_CB)[tz * 256 + j0 + tid] = t; }
        __syncthreads();
    }
}
__device__ __forceinline__ void sincos_f32(float x, float& s, float& c) {
    const float kq = rintf(x * 0.6366197723675814f);
    float y = fmaf(-kq, 1.5703125f, x); y = fmaf(-kq, 4.837512969970703125e-4f, y); y = fmaf(-kq, 7.54978995489188e-8f, y);
    const int q = (int)kq & 3; const float z = y * y;
    const float sp = y + y * z * (-1.6666654611e-1f + z * (8.3321608736e-3f + z * (-1.9515295891e-4f)));
    const float cp = 1.0f - 0.5f * z + z * z * (4.166664568298827e-2f + z * (-1.388731625493765e-3f + z * 2.443315711809948e-5f));
    if (q == 0) { s = sp; c = cp; } else if (q == 1) { s = cp; c = -sp; } else if (q == 2) { s = -sp; c = -cp; } else { s = -cp; c = sp; }
}
__device__ __forceinline__ void rope_tables(const Ctx& C) {
    const long gt = (long)blockIdx.x * NTHREADS + threadIdx.x, gs = (long)gridDim.x * NTHREADS;
    for (long it = gt; it < (long)T_ * 128; it += gs) {
        const int i = (int)(it / T_), t = (int)(it % T_);
        const float inv = exp2f(-(float)(2 * i) / 256.0f * 13.287712379549449f);
        const float ang = (float)C.pos()[t] * inv; float sn, cs; sincos_f32(ang, sn, cs);
        C.w<float>(WS_COS256T)[it] = cs; C.w<float>(WS_SIN256T)[it] = sn;
        C.w<float>(WS_COS256)[(size_t)t * 128 + i] = cs; C.w<float>(WS_SIN256)[(size_t)t * 128 + i] = sn;
    }
    for (long it = gt; it < (long)T_ * 32; it += gs) {
        const int t = (int)(it >> 5), i = (int)(it & 31);
        const float inv = exp2f(-(float)(2 * i) / 64.0f * 13.287712379549449f);
        const float ang = (float)C.pos()[t] * inv; float sn, cs; sincos_f32(ang, sn, cs);
        C.w<float>(WS_COS64)[it] = cs; C.w<float>(WS_SIN64)[it] = sn;
    }
}
__device__ __forceinline__ void modx0_fast(const Ctx& C) {
    const long gt = (long)blockIdx.x * NTHREADS + threadIdx.x, gs = (long)gridDim.x * NTHREADS;
    for (long it = gt; it < (long)T_ * D_ / 8; it += gs) { const long e = it * 8; const int t = (int)(e / D_), c = (int)(e % D_), b = t / S_;
        const f32x4 x0 = *(const f32x4*)(C.f(I_X) + e), x1 = *(const f32x4*)(C.f(I_X) + e + 4);
        const f32x4 s0 = *(const f32x4*)(C.mod(0, b, 1) + c), s1 = *(const f32x4*)(C.mod(0, b, 1) + c + 4), h0 = *(const f32x4*)(C.mod(0, b, 0) + c), h1 = *(const f32x4*)(C.mod(0, b, 0) + c + 4);
        *(u32x4*)(C.w<bf16>(WS_H) + e) = pg8_pack8(x0 * (s0 + 1.0f) + h0, x1 * (s1 + 1.0f) + h1); }
}
__device__ __forceinline__ void ret_gn_fast(const Ctx& C) {
    const int lane = threadIdx.x & 63, wave = threadIdx.x >> 6;
    const bf16* z = C.w<bf16>(WS_QKVG); const bf16* O = C.w<bf16>(WS_RO); bf16* A2 = C.w<bf16>(WS_RA2);
    f32x4 gn_g0[RH], gn_g1[RH], gn_b0[RH], gn_b1[RH];
#pragma unroll
    for (int hh = 0; hh < RH; ++hh) { const float* gg = C.f(I_RET_GN_G) + hh * RDV + 8 * lane; const float* gb = C.f(I_RET_GN_B) + hh * RDV + 8 * lane;
        gn_g0[hh] = *(const f32x4*)gg; gn_g1[hh] = *(const f32x4*)(gg + 4); gn_b0[hh] = *(const f32x4*)gb; gn_b1[hh] = *(const f32x4*)(gb + 4); }
    for (long t = (long)blockIdx.x * 8 + wave; t < T_; t += (long)gridDim.x * 8) {
#pragma unroll
        for (int hh = 0; hh < RH; ++hh) {
            const u32x4 ov = *(const u32x4*)(O + (t * RH + hh) * RDV + 8 * lane), gv = *(const u32x4*)(z + t * RW + 2 * RH * RDK + RH * RDV + hh * RDV + 8 * lane);
            float o[8], g[8];
            { const f32x2_t a = bf2x(ov.x), b2 = bf2x(ov.y), c2 = bf2x(ov.z), d2 = bf2x(ov.w); o[0] = a.x; o[1] = a.y; o[2] = b2.x; o[3] = b2.y; o[4] = c2.x; o[5] = c2.y; o[6] = d2.x; o[7] = d2.y; }
            { const f32x2_t a = bf2x(gv.x), b2 = bf2x(gv.y), c2 = bf2x(gv.z), d2 = bf2x(gv.w); g[0] = a.x; g[1] = a.y; g[2] = b2.x; g[3] = b2.y; g[4] = c2.x; g[5] = c2.y; g[6] = d2.x; g[7] = d2.y; }
            float sm = 0.f;
#pragma unroll
            for (int e = 0; e < 8; ++e) sm += o[e];
            const float mu = wave_sum(sm) * (1.0f / RDV); float q = 0.f;
#pragma unroll
            for (int e = 0; e < 8; ++e) { o[e] -= mu; q += o[e] * o[e]; }
            const float rstd = __builtin_amdgcn_rsqf(wave_sum(q) * (1.0f / RDV) + LN_EPS);
            const f32x4 g0 = gn_g0[hh], g1 = gn_g1[hh], b0 = gn_b0[hh], b1 = gn_b1[hh];
            f32x4 r0, r1;
#pragma unroll
            for (int e = 0; e < 4; ++e) { r0[e] = g[e] * fast_sigmoid(g[e]) * (o[e] * rstd * g0[e] + b0[e]); r1[e] = g[4 + e] * fast_sigmoid(g[4 + e]) * (o[4 + e] * rstd * g1[e] + b1[e]); }
            *(u32x4*)(A2 + (t * RH + hh) * RDV + 8 * lane) = pg8_pack8(r0, r1);
        }
    }
}
template <int R> struct ConvRow { static __device__ __forceinline__ void run(f32x2_t (&acc)[32], const f32x2_t (&wd)[CW], const LAS unsigned* st) {
    const f32x2_t u = bf2x(st[R * 512]);
#pragma unroll
    for (int t = 0; t < 32; ++t) if (R - t >= 0 && R - t < CW) acc[t] += u * wd[(R - t >= 0 && R - t < CW) ? R - t : 0];
    ConvRow<R + 1>::run(acc, wd, st); } };
template <> struct ConvRow<62> { static __device__ __forceinline__ void run(f32x2_t (&)[32], const f32x2_t (&)[CW], const LAS unsigned*) {} };
__device__ __forceinline__ void conv_fast(const Ctx& C, LAS unsigned char* lds) {
    int tid_ = threadIdx.x; asm volatile("" : "+v"(tid_)); const int tid = tid_, lane = tid & 63, wave = tid >> 6;
    const bf16* U = C.w<bf16>(WS_CU); bf16* A2 = C.w<bf16>(WS_CA2);
    LAS unsigned* st = (LAS unsigned*)lds;
    LAS float* of = (LAS float*)lds;
    f32x2_t wd[CW];
#pragma unroll
    for (int w = 0; w < CW; ++w) wd[w] = *(const f32x2_t*)(C.f(I_CONV_W_DW) + w * D_ + 2 * tid);
    const f32x2_t bd = *(const f32x2_t*)(C.f(I_CONV_B_DW) + 2 * tid);
    f32x4 clg[4];
#pragma unroll
    for (int j = 0; j < 4; ++j) clg[j] = *(const f32x4*)(C.f(I_CONV_LN_G) + 4 * lane + 256 * j);
    for (int unit = blockIdx.x; unit < T_ / 32; unit += gridDim.x) {
        const long t0 = (long)unit * 32; const int s0 = (int)(t0 % S_);
        for (int i = tid; i < 62 * 128; i += NTHREADS) { const int r = i >> 7, ch = i & 127; const int sp = s0 - 30 + r;
            u32x4 v = (u32x4){0u, 0u, 0u, 0u}; if (sp >= 0) v = *(const u32x4*)(U + (t0 - 30 + r) * D_ + 8 * ch);
            *(LAS u32x4*)(st + r * 512 + 4 * ch) = v; }
        __syncthreads();
        f32x2_t acc[32];
#pragma unroll
        for (int t = 0; t < 32; ++t) acc[t] = bd;
        ConvRow<0>::run(acc, wd, st + tid);
        __syncthreads();
#pragma unroll
        for (int t = 0; t < 32; ++t) *(LAS f32x2_t*)(of + t * D_ + 2 * tid) = acc[t];
        __syncthreads();
#pragma unroll
        for (int rr = 0; rr < 4; ++rr) { const int r = wave * 4 + rr; f32x4 v[4]; float sm = 0.f;
#pragma unroll
            for (int j = 0; j < 4; ++j) { v[j] = *(const LAS f32x4*)(of + r * D_ + 4 * lane + 256 * j); sm += (v[j][0] + v[j][1]) + (v[j][2] + v[j][3]); }
            const float mu = wave_sum(sm) * (1.0f / D_); float q = 0.f;
#pragma unroll
            for (int j = 0; j < 4; ++j) { v[j] = v[j] - mu; q += (v[j][0] * v[j][0] + v[j][1] * v[j][1]) + (v[j][2] * v[j][2] + v[j][3] * v[j][3]); }
            const float rstd = __builtin_amdgcn_rsqf(wave_sum(q) * (1.0f / D_) + LN_EPS);
#pragma unroll
            for (int j = 0; j < 4; ++j) { f32x4 y = v[j] * rstd * clg[j] + *(const f32x4*)(C.f(I_CONV_LN_B) + 4 * lane + 256 * j);
#pragma unroll
                for (int e = 0; e < 4; ++e) y[e] = y[e] * fast_sigmoid(y[e]);
                u32x2 p; p.x = cvt_pk_bf16(y[0], y[1]); p.y = cvt_pk_bf16(y[2], y[3]); *(u32x2*)(A2 + (t0 + r) * D_ + 4 * lane + 256 * j) = p; } }
        __syncthreads();
    }
}
__device__ __forceinline__ void pool_fast(const Ctx& C, LAS unsigned char* lds) {
    const int tid = threadIdx.x; const bf16* H = C.w<bf16>(WS_H); bf16* PL = C.w<bf16>(WS_PL);
    LAS unsigned* st = (LAS unsigned*)lds;
    const int win = 2 << (tid >> 7);
    for (int unit = blockIdx.x; unit < T_ / 32; unit += gridDim.x) {
        const long t0 = (long)unit * 32; const int s0 = (int)(t0 % S_);
#pragma unroll
        for (int kb = 0; kb < 12; kb += 6) { u32x4 sv[6];
#pragma unroll
          for (int k = 0; k < 6; ++k) { const int i = tid + (kb + k) * NTHREADS, r = i >> 7, ch = i & 127; const int sp = s0 - 15 + r;
              sv[k] = (u32x4){0u, 0u, 0u, 0u}; if (i < 47 * 128 && sp >= 0) sv[k] = *(const u32x4*)(H + (t0 - 15 + r) * D_ + 8 * ch); }
#pragma unroll
          for (int k = 0; k < 6; ++k) { const int i = tid + (kb + k) * NTHREADS, r = i >> 7, ch = i & 127; if (i < 47 * 128) *(LAS u32x4*)(st + r * 512 + 4 * ch) = sv[k]; } }
        __syncthreads();
        f32x2_t sum = (f32x2_t){0.f, 0.f};
        for (int w = 1; w < win; ++w) sum += bf2x(st[(15 - w) * 512 + tid]);
#pragma unroll 4
        for (int t = 0; t < 32; ++t) { const f32x2_t hv = bf2x(st[(15 + t) * 512 + tid]); sum += hv;
            const int s = s0 + t; const int cnt = s + 1 < win ? s + 1 : win;
            const f32x2_t o = sum * (1.0f / (float)cnt) - hv;
            *(unsigned*)(PL + (t0 + t) * D_ + 2 * tid) = cvt_pk_bf16(o.x, o.y);
            sum -= bf2x(st[(15 + t - win + 1) * 512 + tid]); }
        __syncthreads();
    }
}


constexpr int RC = 32;
constexpr int RQ_LD = 264, RKT_LD = 40, RST_LD = 264;
__device__ __forceinline__ void ret_core_fast(const Ctx& C, LAS unsigned char* lds) {
    int tid_ = threadIdx.x; asm volatile("" : "+v"(tid_)); const int tid = tid_, lane = tid & 63, wave = __builtin_amdgcn_readfirstlane(tid >> 6), c = lane & 31, hh = lane >> 5;
    LAS bf16* Qs = (LAS bf16*)lds; LAS bf16* Ks = Qs + 32 * RQ_LD; LAS bf16* KTs = Ks + 32 * RQ_LD; LAS bf16* VP = KTs + 256 * RKT_LD; LAS bf16* VD = VP + 64 * RKT_LD;
    LAS bf16* ST = VD + 64 * RKT_LD; LAS float* XCH = (LAS float*)(ST + 64 * RST_LD);
    const bf16* z = C.w<bf16>(WS_QKVG); const bf16* KTg = C.w<bf16>(WS_KT); const bf16* VTg = C.w<bf16>(WS_VT); bf16* RO = C.w<bf16>(WS_RO);
    for (int unit = blockIdx.x; unit < NB * RH * 8; unit += gridDim.x) {
        const int vs = (unit >> 3) & 7, bh = (unit & 7) * 4 + (unit >> 6), h = bh % RH, b = bh / RH; const size_t tb = (size_t)b * S_;
        const float lg2 = log2f(1.0f - exp2f(-5.0f - (float)h));
        for (int i = tid; i < 64 * RST_LD / 2; i += NTHREADS) ((LAS unsigned*)ST)[i] = 0u;
        u32x4 rq0[2], rk0[2], rv0, rq1[2], rk1[2], rv1;
#define RET_LOAD(ch, S) do { const size_t t0_ = tb + (size_t)(ch) * RC; \
        _Pragma("unroll") for (int i_ = 0; i_ < 2; ++i_) { const int p_ = tid + i_ * NTHREADS, r_ = p_ >> 5, cc_ = p_ & 31; \
            rq##S[i_] = *(const u32x4*)(z + (t0_ + r_) * RW + h * RDK + 8 * cc_); rk##S[i_] = *(const u32x4*)(z + (t0_ + r_) * RW + RH * RDK + h * RDK + 8 * cc_); \
            } \
        if (tid < 256) rv##S = *(const u32x4*)(VTg + ((size_t)h * RDV + vs * 64 + (tid >> 2)) * T_ + t0_ + 8 * (tid & 3)); } while (0)
#define RET_STORE(S) do { \
        _Pragma("unroll") for (int i_ = 0; i_ < 2; ++i_) { const int p_ = tid + i_ * NTHREADS, r_ = p_ >> 5, cc_ = p_ & 31; \
            *(LAS u32x4*)(Qs + r_ * RQ_LD + 8 * cc_) = rq##S[i_]; *(LAS u32x4*)(Ks + r_ * RQ_LD + 8 * cc_) = rk##S[i_]; \
            } \
        if (tid < 256) { const int v_ = tid >> 2, q_ = tid & 3;       \
            const int g0_ = 2 * q_, g1_ = 2 * q_ + 1; \
            const int p0_ = (g0_ & ~3) | ((g0_ & 3) == 1 ? 2 : (g0_ & 3) == 2 ? 1 : (g0_ & 3)), p1_ = (g1_ & ~3) | ((g1_ & 3) == 1 ? 2 : (g1_ & 3) == 2 ? 1 : (g1_ & 3)); \
            *(LAS u32x2*)(VP + v_ * RKT_LD + 4 * p0_) = (u32x2){rv##S.x, rv##S.y}; *(LAS u32x2*)(VP + v_ * RKT_LD + 4 * p1_) = (u32x2){rv##S.z, rv##S.w}; \
            const f32x2_t a_ = bf2x(rv##S.x), b_ = bf2x(rv##S.y), c_ = bf2x(rv##S.z), d2_ = bf2x(rv##S.w); u32x4 w_; \
            w_.x = cvtpk(a_.x * vdec[0], a_.y * vdec[1]); w_.y = cvtpk(b_.x * vdec[2], b_.y * vdec[3]); \
            w_.z = cvtpk(c_.x * vdec[4], c_.y * vdec[5]); w_.w = cvtpk(d2_.x * vdec[6], d2_.y * vdec[7]); \
            *(LAS u32x4*)(VD + v_ * RKT_LD + 8 * q_) = w_; } } while (0)
        float vdec[8];
#pragma unroll
        for (int k = 0; k < 8; ++k) vdec[k] = __builtin_amdgcn_exp2f(lg2 * (float)(RC - 1 - 8 * (tid & 3) - k));
        RET_LOAD(0, 0); RET_STORE(0); RET_LOAD(1, 1);
        __syncthreads();
        f32x16 Sm[2];
#pragma unroll
        for (int k = 0; k < 2; ++k)
#pragma unroll
            for (int i = 0; i < 16; ++i) Sm[k][i] = 0.f;
        const float dchunk = __builtin_amdgcn_exp2f(lg2 * (float)RC);
        f32x16 dmask;
#pragma unroll
        for (int i = 0; i < 16; ++i) { const int j = crow32(i, hh); dmask[i] = j <= c ? __builtin_amdgcn_exp2f(lg2 * (float)(c - j)) : 0.f; }
        const float dq = __builtin_amdgcn_exp2f(lg2 * (float)(c + 1));
        constexpr int NCHK = S_ / RC;
#pragma unroll 2
        for (int ch = 0; ch < NCHK; ++ch) {
            if (ch + 2 < NCHK) { if ((ch & 1) == 0) RET_LOAD(ch + 2, 0); else RET_LOAD(ch + 2, 1); }
            f32x16 Oi[2];
            if (wave == 0) {
                f32x16 St;
#pragma unroll
                for (int i = 0; i < 16; ++i) St[i] = 0.f;
#pragma unroll 4
                for (int sx = 0; sx < 16; ++sx) { const bf16x8 a0 = *(const LAS bf16x8*)(Ks + c * RQ_LD + 16 * sx + 8 * hh), q0 = *(const LAS bf16x8*)(Qs + c * RQ_LD + 16 * sx + 8 * hh);
                    St = __builtin_amdgcn_mfma_f32_32x32x16_bf16(a0, q0, St, 0, 0, 0); }
#pragma unroll
                for (int i = 0; i < 16; ++i) St[i] *= dmask[i];
#pragma unroll
                for (int vb = 0; vb < 2; ++vb) {
#pragma unroll
                    for (int i = 0; i < 16; ++i) Oi[vb][i] = 0.f;
#pragma unroll
                    for (int ks = 0; ks < 2; ++ks) { u32x4 pw; pw.x = cvtpk(St[8 * ks + 0], St[8 * ks + 1]); pw.y = cvtpk(St[8 * ks + 2], St[8 * ks + 3]); pw.z = cvtpk(St[8 * ks + 4], St[8 * ks + 5]); pw.w = cvtpk(St[8 * ks + 6], St[8 * ks + 7]);
                        const bf16x8 a = *(const LAS bf16x8*)(VP + (32 * vb + c) * RKT_LD + 16 * ks + 8 * hh);
                        Oi[vb] = __builtin_amdgcn_mfma_f32_32x32x16_bf16(a, __builtin_bit_cast(bf16x8, pw), Oi[vb], 0, 0, 0); } }
            } else if (wave < 3) {
                const int vb = wave - 1; f32x16 Oc;
#pragma unroll
                for (int i = 0; i < 16; ++i) Oc[i] = 0.f;
#pragma unroll 4
                for (int sx = 0; sx < 16; ++sx) { const bf16x8 a0 = *(const LAS bf16x8*)(ST + (32 * vb + c) * RST_LD + 16 * sx + 8 * hh), q0 = *(const LAS bf16x8*)(Qs + c * RQ_LD + 16 * sx + 8 * hh);
                    Oc = __builtin_amdgcn_mfma_f32_32x32x16_bf16(a0, q0, Oc, 0, 0, 0); }
#pragma unroll
                for (int i = 0; i < 16; ++i) XCH[(vb * 16 + i) * 64 + lane] = Oc[i];
            }
            bf16x8 kta[2];
#pragma unroll
            for (int ks = 0; ks < 2; ++ks)
#pragma unroll
                for (int jj = 0; jj < 8; ++jj) kta[ks][jj] = (short)Ks[(16 * ks + 8 * hh + jj) * RQ_LD + 32 * wave + c];
#pragma unroll
            for (int vb = 0; vb < 2; ++vb) {
#pragma unroll
                for (int i = 0; i < 16; ++i) Sm[vb][i] *= dchunk;
#pragma unroll
                for (int ks = 0; ks < 2; ++ks) { const bf16x8 bv = *(const LAS bf16x8*)(VD + (32 * vb + c) * RKT_LD + 16 * ks + 8 * hh);
                    Sm[vb] = __builtin_amdgcn_mfma_f32_32x32x16_bf16(kta[ks], bv, Sm[vb], 0, 0, 0); } }
            __syncthreads();
            if (ch + 1 < NCHK) { if ((ch & 1) == 0) RET_STORE(1); else RET_STORE(0); }
            if (wave == 0) {
                const size_t t = tb + (size_t)ch * RC + c;
#pragma unroll
                for (int vb = 0; vb < 2; ++vb)
#pragma unroll
                    for (int k2 = 0; k2 < 2; ++k2) { u32x2 w[2];
#pragma unroll
                        for (int qq = 0; qq < 2; ++qq) { const int q4 = 2 * k2 + qq; float o[4];
#pragma unroll
                            for (int e = 0; e < 4; ++e) o[e] = Oi[vb][4 * q4 + e] + dq * XCH[(vb * 16 + 4 * q4 + e) * 64 + lane];
                            w[qq].x = cvtpk(o[0], o[1]); w[qq].y = cvtpk(o[2], o[3]); }
                        const auto rx = __builtin_amdgcn_permlane32_swap(w[0].x, w[1].x, false, false), ry = __builtin_amdgcn_permlane32_swap(w[0].y, w[1].y, false, false);
                        *(u32x4*)(RO + t * (RH * RDV) + h * RDV + vs * 64 + 32 * vb + 16 * k2 + 8 * hh) = (u32x4){rx[0], ry[0], rx[1], ry[1]}; }
            }
#pragma unroll
            for (int vb = 0; vb < 2; ++vb)
#pragma unroll
                for (int q4 = 0; q4 < 4; ++q4) { u32x2 w; w.x = cvtpk(Sm[vb][4 * q4 + 0], Sm[vb][4 * q4 + 1]); w.y = cvtpk(Sm[vb][4 * q4 + 2], Sm[vb][4 * q4 + 3]);
                    *(LAS u32x2*)(ST + (32 * vb + c) * RST_LD + 32 * wave + 8 * q4 + 4 * hh) = w; }
            __syncthreads();
        }
#undef RET_LOAD
#undef RET_STORE
    }
}

namespace pg8 {
constexpr int BM = 256, BK = 64, HALF = 128, HTB = HALF * BK * 2, STAGE_BYTES = 8 * HTB;
__device__ __forceinline__ int lds_byte(int r, int c) { const int st = (r >> 4) * 2 + (c >> 5), rr = r & 15, cc = c & 31, ob = rr * 64 + cc * 2; return st * 1024 + (ob ^ (((ob >> 9) & 1) << 5)); }
__device__ __forceinline__ void stage_rc(int b, int& R, int& Cc) { const int st = b / 1024, sb = b % 1024, swz = sb ^ (((sb >> 9) & 1) << 5); R = (st >> 1) * 16 + swz / 64; Cc = (st & 1) * 32 + (swz % 64) / 2; }
__device__ __forceinline__ int perm32(int rho) { const int n = rho >> 4, i = rho & 15; return 8 * (i >> 2) + 4 * n + (i & 3); }
struct Unit { const char* A; const char* B; int pm, pn, z, nrows, aux; };
struct GemmP { int K; unsigned ldb_b, kstepA; int kwrap = 0; };
typedef f32x4 Acc[2][2][4][2];

typedef int v4i __attribute__((ext_vector_type(4)));
typedef int v8i __attribute__((ext_vector_type(8)));
template <class Epi, class Sched, bool ALIGN_EPI, bool FP8 = false>
__device__ __forceinline__ void gemm8(LAS unsigned char* lds, const GemmP P, const Sched& S, const Epi& E) {
    int tid_ = threadIdx.x; asm volatile("" : "+v"(tid_)); const int tid = tid_, wid = __builtin_amdgcn_readfirstlane(tid >> 6), lane = tid & 63, wr = wid >> 2, wc = wid & 3, fr = lane & 15, fq = lane >> 4;
    int nt = P.K / BK; asm volatile("" : "+s"(nt));
    int Rr[2], Cb[2]; unsigned voffB[2];
#pragma unroll
    for (int i = 0; i < 2; ++i) { int R, Cc; stage_rc(tid * 16 + i * 8192, R, Cc); Rr[i] = R; Cb[i] = Cc * 2; const int Rb = (R & ~31) + perm32(R & 31); voffB[i] = (unsigned)Rb * P.ldb_b + (unsigned)Cc * 2u; }
    const size_t kstepA = P.kstepA, kstepB = BK * 2, hstepB = (size_t)HALF * P.ldb_b;
    const unsigned ldsw = (unsigned)wid * 1024u;
    const int aoff = lds_byte(wr * 64 + fr, fq * 8), boff = lds_byte(wc * 32 + fr, fq * 8);
#define PG8_SA(b, h) (((b) * 2 + (h)) * HTB)
#define PG8_SB(b, h) ((4 + (b) * 2 + (h)) * HTB)
#define PG8_STAGE(bufoff, gbase, voff) do { _Pragma("unroll") for (int _i = 0; _i < 2; ++_i) \
        __builtin_amdgcn_global_load_lds((const unsigned*)((const char*)(gbase) + (voff)[_i]), (LAS unsigned*)(lds + (bufoff) + ldsw + _i * 8192), 16, 0, 0); } while (0)
#define PG8_LDA(dst, b, h) do { if constexpr (FP8) { _Pragma("unroll") for (int m = 0; m < 4; ++m) { const v4i l0_ = *(const LAS v4i*)(lds + PG8_SA(b, h) + aoff + m * 2048), l1_ = *(const LAS v4i*)(lds + PG8_SA(b, h) + aoff + m * 2048 + 1024); \
        dst##8[m] = __builtin_shufflevector(l0_, l1_, 0, 1, 2, 3, 4, 5, 6, 7); } } else { \
        _Pragma("unroll") for (int m = 0; m < 4; ++m) _Pragma("unroll") for (int k = 0; k < 2; ++k) dst[m][k] = *(const LAS bf16x8*)(lds + PG8_SA(b, h) + aoff + m * 2048 + k * 1024); } } while (0)
#define PG8_LDB(dst, b, h) do { if constexpr (FP8) { _Pragma("unroll") for (int n = 0; n < 2; ++n) { const v4i l0_ = *(const LAS v4i*)(lds + PG8_SB(b, h) + boff + n * 2048), l1_ = *(const LAS v4i*)(lds + PG8_SB(b, h) + boff + n * 2048 + 1024); \
        dst##8[n] = __builtin_shufflevector(l0_, l1_, 0, 1, 2, 3, 4, 5, 6, 7); } } else { \
        _Pragma("unroll") for (int n = 0; n < 2; ++n) _Pragma("unroll") for (int k = 0; k < 2; ++k) dst[n][k] = *(const LAS bf16x8*)(lds + PG8_SB(b, h) + boff + n * 2048 + k * 1024); } } while (0)
#define PG8_MMA(ai, bj, At, Bt) do { __builtin_amdgcn_s_setprio(1); if constexpr (FP8) { _Pragma("unroll") for (int m = 0; m < 4; ++m) _Pragma("unroll") for (int n = 0; n < 2; ++n) \
        acc[ai][bj][m][n] = __builtin_amdgcn_mfma_scale_f32_16x16x128_f8f6f4(Bt##8[n], At##8[m], acc[ai][bj][m][n], 0, 0, 0, 0x7f7f7f7f, 0, 0x7f7f7f7f); } else { \
        _Pragma("unroll") for (int m = 0; m < 4; ++m) _Pragma("unroll") for (int n = 0; n < 2; ++n) _Pragma("unroll") for (int k = 0; k < 2; ++k) \
        acc[ai][bj][m][n] = __builtin_amdgcn_mfma_f32_16x16x32_bf16(Bt[n][k], At[m][k], acc[ai][bj][m][n], 0, 0, 0); } __builtin_amdgcn_s_setprio(0); } while (0)
#define PG8_WAIT_V(n) asm volatile("s_waitcnt vmcnt(" #n ")" ::: "memory")
#define PG8_WAIT_L(n) asm volatile("s_waitcnt lgkmcnt(" #n ")" ::: "memory")
#define PG8_BAR __builtin_amdgcn_s_barrier()
#define PG8_SCHED __builtin_amdgcn_sched_barrier(0)
#define PG8_ROWOFFS(u, v) do { _Pragma("unroll") for (int _h = 0; _h < 2; ++_h) _Pragma("unroll") for (int _i = 0; _i < 2; ++_i) { unsigned _o = S.row_off(u, _h * 128 + Rr[_i]) + (unsigned)Cb[_i]; asm volatile("" : "+v"(_o)); v[_h][_i] = _o;     } } while (0)
#define PG8_ROWIDX(u, p) do { _Pragma("unroll") for (int _h = 0; _h < 2; ++_h) _Pragma("unroll") for (int _i = 0; _i < 2; ++_i) p[_h][_i] = S.row_idx(u, _h * 128 + Rr[_i]); } while (0)
    Unit cur, nxt; int ui = 0;
    if (!S.next(0, cur)) return;
    Acc acc;
#pragma unroll
    for (int a = 0; a < 2; ++a)
#pragma unroll
        for (int b = 0; b < 2; ++b)
#pragma unroll
            for (int m = 0; m < 4; ++m)
#pragma unroll
                for (int n = 0; n < 2; ++n) acc[a][b][m][n] = (f32x4){0.f, 0.f, 0.f, 0.f};
    bf16x8 At[4][2], B0[2][2], B1[2][2];
    v8i At8[4], B08[2], B18[2];
    (void)At; (void)B0; (void)B1; (void)At8; (void)B08; (void)B18;
    unsigned va[2][2], na[2][2]; int pend[2][2] = {{0, 0}, {0, 0}};
    PG8_ROWOFFS(cur, va);
    if constexpr (Sched::GATHER) { Unit n1, n2; if (S.next(1, n1)) { PG8_ROWOFFS(n1, na); } else {
#pragma unroll
            for (int h = 0; h < 2; ++h)
#pragma unroll
                for (int i = 0; i < 2; ++i) na[h][i] = va[h][i]; }
        if (S.next(2, n2)) PG8_ROWIDX(n2, pend); }
    float epf = 0.f; if constexpr (Epi::HAS_PRE) epf = E.pre(cur, tid);
    LAS float* const prebuf = (LAS float*)(lds + 133120);
    const char* cA = cur.A; const char* cB = cur.B;
    PG8_STAGE(PG8_SB(0, 0), cB, voffB); PG8_STAGE(PG8_SB(0, 1), cB + hstepB, voffB); PG8_STAGE(PG8_SA(0, 0), cA, va[0]); PG8_STAGE(PG8_SA(0, 1), cA, va[1]);
    if (wr == 1) PG8_BAR;
    PG8_WAIT_V(2); PG8_BAR;
    PG8_STAGE(PG8_SB(1, 0), cB + kstepB, voffB); PG8_STAGE(PG8_SA(1, 0), cA + kstepA, va[0]); PG8_STAGE(PG8_SB(1, 1), cB + hstepB + kstepB, voffB);
    PG8_WAIT_V(6); PG8_BAR;
    for (;;) {
        const bool has_next = S.next(ui + 1, nxt);
        const char* nA = has_next ? nxt.A : cA; const char* nB = has_next ? nxt.B : cB;
        if constexpr (!Sched::GATHER) {
            if (has_next) { PG8_ROWOFFS(nxt, na); } else {
#pragma unroll
                for (int h = 0; h < 2; ++h)
#pragma unroll
                    for (int i = 0; i < 2; ++i) na[h][i] = va[h][i]; } }
        for (int t = 0; t < nt; t += 2) {
            const bool last = (t == nt - 2);
            const int w1_ = P.kwrap ? (t + 1) % P.kwrap : t + 1, w2_ = P.kwrap ? (t + 2) % P.kwrap : t + 2;
            const char* a1 = cA + (size_t)w1_ * kstepA;
            const char* a2 = last ? nA : cA + (size_t)w2_ * kstepA; const char* b2 = last ? nB : cB + (size_t)w2_ * kstepB;
            const char* a3 = a2 + kstepA; const char* b3 = b2 + kstepB;
            PG8_LDB(B0, 0, 0); PG8_LDB(B1, 0, 1); PG8_SCHED; PG8_LDA(At, 0, 0); PG8_STAGE(PG8_SA(1, 1), a1, va[1]);
            if (last) {
#pragma unroll
                for (int h = 0; h < 2; ++h)
#pragma unroll
                    for (int i = 0; i < 2; ++i) va[h][i] = na[h][i]; }
            PG8_WAIT_V(8); PG8_WAIT_L(0); PG8_BAR; PG8_MMA(0, 0, At, B0); PG8_MMA(0, 1, At, B1); PG8_BAR; PG8_SCHED;
            PG8_LDA(At, 0, 1); PG8_STAGE(PG8_SB(0, 0), b2, voffB); PG8_STAGE(PG8_SB(0, 1), b2 + hstepB, voffB); PG8_STAGE(PG8_SA(0, 0), a2, va[0]);
            PG8_WAIT_V(8); PG8_WAIT_L(0); PG8_BAR; PG8_MMA(1, 0, At, B0); PG8_MMA(1, 1, At, B1); PG8_BAR; PG8_SCHED;
            PG8_LDB(B0, 1, 0); PG8_LDB(B1, 1, 1); PG8_SCHED; PG8_LDA(At, 1, 0); PG8_STAGE(PG8_SA(0, 1), a2, va[1]);
            PG8_WAIT_V(8); PG8_WAIT_L(0); PG8_BAR; PG8_MMA(0, 0, At, B0); PG8_MMA(0, 1, At, B1); PG8_BAR; PG8_SCHED;
            PG8_LDA(At, 1, 1); PG8_STAGE(PG8_SB(1, 0), b3, voffB); PG8_STAGE(PG8_SB(1, 1), b3 + hstepB, voffB); PG8_STAGE(PG8_SA(1, 0), a3, va[0]);
            PG8_WAIT_V(8); PG8_WAIT_L(0); PG8_BAR; PG8_MMA(1, 0, At, B0); PG8_MMA(1, 1, At, B1); PG8_BAR; PG8_SCHED;
        }
        if constexpr (Sched::GATHER) { Unit n2, n3;
            if (S.next(ui + 2, n2)) {
#pragma unroll
                for (int h = 0; h < 2; ++h)
#pragma unroll
                    for (int i = 0; i < 2; ++i) { unsigned o = S.idx_off(pend[h][i]) + (unsigned)Cb[i]; asm volatile("" : "+v"(o)); na[h][i] = o; } }
            if (S.next(ui + 3, n3)) PG8_ROWIDX(n3, pend); }
        float epf_n = 0.f; if constexpr (Epi::HAS_PRE) { if (has_next) epf_n = E.pre(nxt, tid); }
        if constexpr (ALIGN_EPI) { if (wr == 0) PG8_BAR; }
        if constexpr (Epi::HAS_PRE) { static_assert(ALIGN_EPI, "the LDS bias hand-off needs both half-workgroups aligned");
            if (tid < 256) prebuf[tid] = epf; PG8_WAIT_L(0); PG8_BAR; epf = epf_n; }
        { int fr_ = fr, fq_ = fq; asm volatile("" : "+v"(fr_), "+v"(fq_));
          if constexpr (Epi::HAS_PRE) { E(acc, cur, wr, wc, fr_, fq_, prebuf); if (PROBE_KIND == 11) { asm volatile("" : "+v"(fr_)); E(acc, cur, wr, wc, fr_, fq_, prebuf); } } else E(acc, cur, wr, wc, fr_, fq_); }
        if (!has_next) break;
#pragma unroll
        for (int a = 0; a < 2; ++a)
#pragma unroll
            for (int b = 0; b < 2; ++b)
#pragma unroll
                for (int m = 0; m < 4; ++m)
#pragma unroll
                    for (int n = 0; n < 2; ++n) acc[a][b][m][n] = (f32x4){0.f, 0.f, 0.f, 0.f};
        cur = nxt; cA = nA; cB = nB; ++ui;
        if constexpr (ALIGN_EPI) { if (wr == 1) PG8_BAR; }
    }
    PG8_WAIT_V(0);
    if constexpr (!ALIGN_EPI) { if (wr == 0) PG8_BAR; }
    PG8_BAR;
#undef PG8_SA
#undef PG8_SB
#undef PG8_STAGE
#undef PG8_LDA
#undef PG8_LDB
#undef PG8_MMA
#undef PG8_WAIT_V
#undef PG8_WAIT_L
#undef PG8_BAR
#undef PG8_SCHED
#undef PG8_ROWOFFS
#undef PG8_ROWIDX
}

struct DenseSched {           static constexpr bool GATHER = false;
    const char* A0; const char* B0; unsigned lda_b; size_t a_pn_b, b_pn_b; int nM, nN, nwg, G, c;
    __device__ __forceinline__ void init(const void* A, unsigned lda_bytes, const void* B, size_t b_pn_bytes, int M, int N, size_t a_pn_bytes = 0) {
        A0 = (const char*)A; B0 = (const char*)B; lda_b = lda_bytes; a_pn_b = a_pn_bytes; b_pn_b = b_pn_bytes; nM = M / 256; nN = N / 256; nwg = nM * nN; G = gridDim.x; c = blockIdx.x; }
    __device__ __forceinline__ bool next(int i, Unit& u) const {
        const long L = (long)i * G + c; if (L >= nwg) return false;
        int wgid = (int)L; { const int q = nwg / 8, r = nwg % 8, xcd = wgid % 8, off = wgid / 8; wgid = (xcd < r ? xcd * (q + 1) : r * (q + 1) + (xcd - r) * q) + off; }
        const int nig = 8 * nN, gid = wgid / nig, fm = gid * 8, gsz = (nM - fm) < 8 ? (nM - fm) : 8;
        u.pm = fm + ((wgid % nig) % gsz); u.pn = (wgid % nig) / gsz; u.z = 0; u.nrows = 256; u.aux = 0;
        u.A = A0 + (size_t)u.pm * 256 * lda_b + (size_t)u.pn * a_pn_b; u.B = B0 + (size_t)u.pn * b_pn_b; return true; }
    __device__ __forceinline__ unsigned row_off(const Unit&, int r) const { return (unsigned)r * lda_b; }
};
struct MoeSched {
    static constexpr bool GATHER = true;
    const int* cnt; const int* list; const char* A0; const char* B0; size_t b_e_b, b_pn_b; unsigned lda_b; int npn, G, c; const LAS int* tab;
    __device__ __forceinline__ void build(LAS int* tabw) {
        if (threadIdx.x < 32) { const int i = threadIdx.x; long L = (long)i * G + c; int tb = 0, fe = -1, fpm = 0, fpl = 0, fpn = 0;
            for (int e = 0; e < NE; ++e) { const int nt = (cnt[e] + 255) >> 8; const long nu = (long)nt * npn;
                if (fe < 0 && L < nu) { fe = e; fpl = (int)(L / npn); fpn = (int)(L % npn); fpm = tb + fpl; }
                L -= nu; tb += nt; }
            int nr = 0; if (fe >= 0) { nr = cnt[fe] - fpl * 256; nr = nr < 256 ? nr : 256; }
            tabw[4 * i + 0] = fe; tabw[4 * i + 1] = fpm; tabw[4 * i + 2] = fpl | (nr << 16); tabw[4 * i + 3] = fpn; }
        tab = tabw; __syncthreads(); }
    __device__ __forceinline__ bool next(int i, Unit& u) const {
        if (i >= 32) return false;
        const v4i ent = *(const LAS v4i*)(tab + 4 * i);
        const int e = __builtin_amdgcn_readfirstlane(ent[0]); if (e < 0) return false;
        u.z = e; u.pm = __builtin_amdgcn_readfirstlane(ent[1]); const int an = __builtin_amdgcn_readfirstlane(ent[2]); u.aux = an & 0xffff; u.nrows = an >> 16; u.pn = __builtin_amdgcn_readfirstlane(ent[3]);
        u.A = A0;       u.B = B0 + (size_t)e * b_e_b + (size_t)u.pn * b_pn_b; return true; }
    __device__ __forceinline__ int row_idx(const Unit& u, int r) const { const int rr = r < u.nrows ? r : u.nrows - 1; return list[(size_t)u.z * T_ + u.aux * 256 + rr]; }
    __device__ __forceinline__ unsigned idx_off(int idx) const { return (unsigned)idx * lda_b; }
    __device__ __forceinline__ unsigned row_off(const Unit& u, int r) const { return idx_off(row_idx(u, r)); }
};
struct MoeSchedC : MoeSched {
    static constexpr bool GATHER = false;
    __device__ __forceinline__ bool next(int i, Unit& u) const { if (!MoeSched::next(i, u)) return false; u.A = A0 + (size_t)u.pm * 256 * lda_b; return true; }
    __device__ __forceinline__ unsigned row_off(const Unit&, int r) const { return (unsigned)r * lda_b; }
};

#define EPI_ROWS_BEGIN _Pragma("unroll") for (int ai = 0; ai < 2; ++ai) _Pragma("unroll") for (int m = 0; m < 4; ++m) { const int r = ai * 128 + wr * 64 + m * 16 + fr; const int j0 = wc * 32 + fq * 8; (void)j0;
#define EPI_ROWS_END asm volatile("" ::: "memory"); }
__device__ __forceinline__ u32x4 pack8(const f32x4& a, const f32x4& b) { u32x4 w; w.x = cvt_pk_bf16(a[0], a[1]); w.y = cvt_pk_bf16(a[2], a[3]); w.z = cvt_pk_bf16(b[0], b[1]); w.w = cvt_pk_bf16(b[2], b[3]); return w; }
struct EpiMoeUp {
    static constexpr bool HAS_PRE = true;
    const float* b1; unsigned char* ACT;
    __device__ __forceinline__ float pre(const Unit& u, int tid) const { return tid < 256 ? b1[(size_t)u.z * 2 * DFF + (tid >> 7) * DFF + u.pn * 128 + (tid & 127)] : 0.f; }
    __device__ __forceinline__ void operator()(const Acc& acc, const Unit& u, int wr, int wc, int fr, int fq, const LAS float* bb) const {
        const LAS float* bg = bb + wc * 32 + fq * 8;
        const f32x4 g0b = *(const LAS f32x4*)bg, g1b = *(const LAS f32x4*)(bg + 4), u0b = *(const LAS f32x4*)(bg + 128), u1b = *(const LAS f32x4*)(bg + 132);
#pragma unroll
        for (int ai = 0; ai < 2; ++ai)
#pragma unroll
          for (int mp = 0; mp < 2; ++mp) { u32x2 wv[2];
#pragma unroll
            for (int mm = 0; mm < 2; ++mm) { const int m = 2 * mp + mm;
            f32x4 o[2];
#pragma unroll
            for (int n = 0; n < 2; ++n) { const f32x4 gv = acc[ai][0][m][n] * (1.0f / W1_SCALE) + (n ? g1b : g0b), uv = acc[ai][1][m][n] * (1.0f / W1_SCALE) + (n ? u1b : u0b);
                f32x4 gc, uc, sg;
#pragma unroll
                for (int e = 0; e < 4; ++e) { gc[e] = fminf(gv[e], SW_LIMIT); uc[e] = fminf(fmaxf(uv[e], -SW_LIMIT), SW_LIMIT); sg[e] = __builtin_amdgcn_rcpf(1.0f + __builtin_amdgcn_exp2f((-SW_ALPHA * 1.4426950408889634f) * gc[e])); }
                o[n] = (uc * ACT_SCALE + ACT_SCALE) * (gc * sg); }
            wv[mm].x = pk4_fp8(o[0][0], o[0][1], o[0][2], o[0][3]); wv[mm].y = pk4_fp8(o[1][0], o[1][1], o[1][2], o[1][3]); }
            const auto rx = __builtin_amdgcn_permlane16_swap(wv[0].x, wv[1].x, false, false), ry = __builtin_amdgcn_permlane16_swap(wv[0].y, wv[1].y, false, false);
            const int r = ai * 128 + wr * 64 + (2 * mp + (fq & 1)) * 16 + fr, j0 = wc * 32 + (fq & ~1) * 8;
            *(u32x4*)(ACT + ((size_t)u.pm * 256 + r) * DFF + u.pn * 128 + j0) = (u32x4){rx[0], ry[0], rx[1], ry[1]};
            asm volatile("" ::: "memory"); }
    }
};
struct EpiMoeDown {
    static constexpr bool HAS_PRE = true;
    const float* b2; unsigned char* YC;
    __device__ __forceinline__ float pre(const Unit& u, int tid) const { return tid < 256 ? b2[(size_t)u.z * D_ + u.pn * 256 + tid] : 0.f; }
    __device__ __forceinline__ void operator()(const Acc& acc, const Unit& u, int wr, int wc, int fr, int fq, const LAS float* bb) const {
        const LAS float* bp = bb + wc * 32 + fq * 8; constexpr float ds = YC_SCALE / (ACT_SCALE * W2_SCALE);
        f32x4 bv[2][2];
#pragma unroll
        for (int bj = 0; bj < 2; ++bj)
#pragma unroll
            for (int n = 0; n < 2; ++n) bv[bj][n] = *(const LAS f32x4*)(bp + bj * 128 + 4 * n) * YC_SCALE;
#pragma unroll
        for (int ai = 0; ai < 2; ++ai)
#pragma unroll
          for (int mp = 0; mp < 2; ++mp) {
            const int r = ai * 128 + wr * 64 + (2 * mp + (fq & 1)) * 16 + fr, j0 = wc * 32 + (fq & ~1) * 8;
#pragma unroll
            for (int bj = 0; bj < 2; ++bj) { u32x2 wv[2];
#pragma unroll
                for (int mm = 0; mm < 2; ++mm) { const int m = 2 * mp + mm; f32x4 o0 = acc[ai][bj][m][0] * ds + bv[bj][0], o1 = acc[ai][bj][m][1] * ds + bv[bj][1];
#pragma unroll
                    for (int e = 0; e < 4; ++e) { o0[e] = __builtin_amdgcn_fmed3f(o0[e], -448.0f, 448.0f); o1[e] = __builtin_amdgcn_fmed3f(o1[e], -448.0f, 448.0f); }
                    wv[mm].x = pk4_fp8(o0[0], o0[1], o0[2], o0[3]); wv[mm].y = pk4_fp8(o1[0], o1[1], o1[2], o1[3]); }
                const auto rx = __builtin_amdgcn_permlane16_swap(wv[0].x, wv[1].x, false, false), ry = __builtin_amdgcn_permlane16_swap(wv[0].y, wv[1].y, false, false);
                *(u32x4*)(YC + ((size_t)u.pm * 256 + r) * D_ + u.pn * 256 + bj * 128 + j0) = (u32x4){rx[0], ry[0], rx[1], ry[1]}; }
            asm volatile("" ::: "memory"); }
    }
};
struct CmpSched {             static constexpr bool GATHER = false;
    const char* KV; const char* W; int G, c;
    __device__ __forceinline__ bool next(int i, Unit& u) const { const int L = i * G + c; if (L >= 2 * NBG) return false; const int tz = L / NBG, bg = L % NBG, b = bg / NG, g = bg % NG;
        u.z = L; u.pm = 0; u.pn = 0; u.nrows = NCMP; u.aux = 0; u.A = KV + ((size_t)b * S_ * NKVW + tz * 128 + g * 64) * 2; u.B = W + (size_t)tz * 256 * 2048 * 2; return true; }
    __device__ __forceinline__ unsigned row_off(const Unit&, int r) const { return (unsigned)r * (16u * NKVW * 2u); }
};
struct EpiPlain {
    static constexpr bool HAS_PRE = false;
    bf16* O; int ldo; const float* bias;
    __device__ __forceinline__ void operator()(const Acc& acc, const Unit& u, int wr, int wc, int fr, int fq) const {
        f32x4 bv[2][2];
#pragma unroll
        for (int bj = 0; bj < 2; ++bj)
#pragma unroll
            for (int n = 0; n < 2; ++n) bv[bj][n] = bias ? *(const f32x4*)(bias + u.pn * 256 + bj * 128 + wc * 32 + fq * 8 + 4 * n) : (f32x4){0.f, 0.f, 0.f, 0.f};
        EPI_ROWS_BEGIN
#pragma unroll
            for (int bj = 0; bj < 2; ++bj) *(u32x4*)(O + (size_t)(u.pm * 256 + r) * ldo + u.pn * 256 + bj * 128 + j0) = pack8(acc[ai][bj][m][0] + bv[bj][0], acc[ai][bj][m][1] + bv[bj][1]);
        EPI_ROWS_END
    }
};
struct EpiPool {
    static constexpr bool HAS_PRE = false;
    bf16* O; const float* pb; const float* ps;
    __device__ __forceinline__ void operator()(const Acc& acc, const Unit& u, int wr, int wc, int fr, int fq) const {
        f32x4 bv[2][2], sv[2][2];
#pragma unroll
        for (int bj = 0; bj < 2; ++bj)
#pragma unroll
            for (int n = 0; n < 2; ++n) { const int c = u.pn * 256 + bj * 128 + wc * 32 + fq * 8 + 4 * n; bv[bj][n] = *(const f32x4*)(pb + c); sv[bj][n] = *(const f32x4*)(ps + c); }
        EPI_ROWS_BEGIN
#pragma unroll
            for (int bj = 0; bj < 2; ++bj) *(u32x4*)(O + (size_t)(u.pm * 256 + r) * D_ + u.pn * 256 + bj * 128 + j0) = pack8((acc[ai][bj][m][0] + bv[bj][0]) * sv[bj][0], (acc[ai][bj][m][1] + bv[bj][1]) * sv[bj][1]);
        EPI_ROWS_END
    }
};
struct EpiGlu {
    static constexpr bool HAS_PRE = false;
    bf16* U; const float* bias;
    __device__ __forceinline__ void operator()(const Acc& acc, const Unit& u, int wr, int wc, int fr, int fq) const {
        const float* ba = bias + u.pn * 128 + wc * 32 + fq * 8; const float* bg = ba + D_;
        const f32x4 a0 = *(const f32x4*)ba, a1 = *(const f32x4*)(ba + 4), g0 = *(const f32x4*)bg, g1 = *(const f32x4*)(bg + 4);
        EPI_ROWS_BEGIN
            f32x4 o[2];
#pragma unroll
            for (int n = 0; n < 2; ++n) { const f32x4 av = acc[ai][0][m][n] + (n ? a1 : a0), gv = acc[ai][1][m][n] + (n ? g1 : g0);
#pragma unroll
                for (int e = 0; e < 4; ++e) o[n][e] = av[e] * fast_sigmoid(gv[e]); }
            *(u32x4*)(U + (size_t)(u.pm * 256 + r) * D_ + u.pn * 128 + j0) = pack8(o[0], o[1]);
        EPI_ROWS_END
    }
};
__device__ __forceinline__ void rope_store8(const f32x4& x10, const f32x4& x11, const f32x4& x20, const f32x4& x21, const float* cs, const float* sn, float sc, bf16* p1, bf16* p2) {
    const f32x4 c0 = *(const f32x4*)cs, c1 = *(const f32x4*)(cs + 4), s0 = *(const f32x4*)sn, s1 = *(const f32x4*)(sn + 4);
    *(u32x4*)p1 = pack8((x10 * c0 - x20 * s0) * sc, (x11 * c1 - x21 * s1) * sc);
    *(u32x4*)p2 = pack8((x10 * s0 + x20 * c0) * sc, (x11 * s1 + x21 * c1) * sc);
}
struct EpiRetIn {
    static constexpr bool HAS_PRE = false;
    bf16* O; const float* cs; const float* sn;
    __device__ __forceinline__ void operator()(const Acc& acc, const Unit& u, int wr, int wc, int fr, int fq) const {
        const float sc = u.pn >= 4 ? 0.0625f : 1.0f;
        EPI_ROWS_BEGIN
            const size_t t = (size_t)u.pm * 256 + r; bf16* p = O + t * RW + u.pn * 256 + j0;
            if (u.pn < 8) rope_store8(acc[ai][0][m][0], acc[ai][0][m][1], acc[ai][1][m][0], acc[ai][1][m][1], cs + t * 128 + j0, sn + t * 128 + j0, sc, p, p + 128);
            else { *(u32x4*)p = pack8(acc[ai][0][m][0], acc[ai][0][m][1]); *(u32x4*)(p + 128) = pack8(acc[ai][1][m][0], acc[ai][1][m][1]); }
        EPI_ROWS_END
    }
};
struct EpiNsaIn {
    static constexpr bool HAS_PRE = false;
    bf16* Q; bf16* KV; float* GT; const float* gate_b; const float* cs; const float* sn;
    __device__ __forceinline__ void operator()(const Acc& acc, const Unit& u, int wr, int wc, int fr, int fq) const {
        const int i0 = fq * 8;
        EPI_ROWS_BEGIN
            const size_t t = (size_t)u.pm * 256 + r; const f32x4& x10 = acc[ai][0][m][0]; const f32x4& x11 = acc[ai][0][m][1]; const f32x4& x20 = acc[ai][1][m][0]; const f32x4& x21 = acc[ai][1][m][1];
            if (u.pn < 4) { bf16* p = Q + t * D_ + (4 * u.pn + wc) * 64 + i0; rope_store8(x10, x11, x20, x21, cs + t * 32 + i0, sn + t * 32 + i0, 0.125f * 1.4426950408889634f, p, p + 32); }
            else if (u.pn == 4) { bf16* p = KV + t * NKVW + (wc < 2 ? 0 : 256) + (wc & 1) * 64 + i0; rope_store8(x10, x11, x20, x21, cs + t * 32 + i0, sn + t * 32 + i0, 1.0f, p, p + 32); }
            else if (u.pn == 5) {
                if (wc < 2) { bf16* p = KV + t * NKVW + 512 + wc * 64 + i0; rope_store8(x10, x11, x20, x21, cs + t * 32 + i0, sn + t * 32 + i0, 1.0f, p, p + 32); }
                else { bf16* p = KV + t * NKVW + 128 + (j0 - 64); *(u32x4*)p = pack8(x10, x11); *(u32x4*)(p + 64) = pack8(x20, x21); } }
            else if (u.pn == 6) { bf16* p = KV + t * NKVW + 384 + j0; *(u32x4*)p = pack8(x10, x11); *(u32x4*)(p + 256) = pack8(x20, x21); }
            else if (j0 < 48) { float* p = GT + t * 48 + j0; const f32x4 b0 = *(const f32x4*)(gate_b + j0), b1 = *(const f32x4*)(gate_b + j0 + 4); f32x4 o0, o1;
#pragma unroll
                for (int e = 0; e < 4; ++e) { o0[e] = fast_sigmoid(x10[e] + b0[e]); o1[e] = fast_sigmoid(x11[e] + b1[e]); }
                *(f32x4*)p = o0; *(f32x4*)(p + 4) = o1; }
        EPI_ROWS_END
    }
};
struct EpiCmp1 {
    static constexpr bool HAS_PRE = false;
    bf16* H; const float* cb;
    __device__ __forceinline__ void operator()(const Acc& acc, const Unit& u, int wr, int wc, int fr, int fq) const {
        const float* b = cb + (u.z / NBG) * 256 + wc * 32 + fq * 8;
        EPI_ROWS_BEGIN
            if (r < NCMP) {
#pragma unroll
                for (int bj = 0; bj < 2; ++bj) { f32x4 o[2];
#pragma unroll
                    for (int n = 0; n < 2; ++n) { const f32x4 bv = *(const f32x4*)(b + bj * 128 + 4 * n);
#pragma unroll
                        for (int e = 0; e < 4; ++e) o[n][e] = gelu_tanh(acc[ai][bj][m][n][e] + bv[e]); }
                    *(u32x4*)(H + ((size_t)u.z * 256 + r) * 256 + bj * 128 + j0) = pack8(o[0], o[1]); } }
        EPI_ROWS_END
    }
};
struct EpiRopeT {
    static constexpr bool HAS_PRE = false;
    bf16* KT; const float* csT; const float* snT;
    __device__ __forceinline__ void operator()(const Acc& acc, const Unit& u, int wr, int wc, int fr, int fq) const {
#pragma unroll
        for (int m = 0; m < 4; ++m) { const int i = wr * 64 + m * 16 + fr;
#pragma unroll
            for (int bj = 0; bj < 2; ++bj) { const size_t t0 = (size_t)u.pn * 256 + bj * 128 + wc * 32 + fq * 8;
                const f32x4 c0 = *(const f32x4*)(csT + (size_t)i * T_ + t0), c1 = *(const f32x4*)(csT + (size_t)i * T_ + t0 + 4), s0 = *(const f32x4*)(snT + (size_t)i * T_ + t0), s1 = *(const f32x4*)(snT + (size_t)i * T_ + t0 + 4);
                const f32x4& x10 = acc[0][bj][m][0]; const f32x4& x11 = acc[0][bj][m][1]; const f32x4& x20 = acc[1][bj][m][0]; const f32x4& x21 = acc[1][bj][m][1];
                *(u32x4*)(KT + ((size_t)u.pm * 256 + i) * T_ + t0) = pack8((x10 * c0 - x20 * s0) * 0.0625f, (x11 * c1 - x21 * s1) * 0.0625f);
                *(u32x4*)(KT + ((size_t)u.pm * 256 + 128 + i) * T_ + t0) = pack8((x10 * s0 + x20 * c0) * 0.0625f, (x11 * s1 + x21 * c1) * 0.0625f); }
            asm volatile("" ::: "memory"); }
    }
};
}
#endif

constexpr int PH_PER_LAYER = 24, PH_TOTAL = 1 + DEPTH * PH_PER_LAYER;

#ifdef HOSTTEST
#define PH(id, ...) do { if (ph_lo <= (id) && (id) < ph_hi) { __VA_ARGS__; } } while (0)
#define LAYER_ARGS const Ctx& C, int ph_lo, int ph_hi
#define LAYER_PASS C, ph_lo, ph_hi
#define LAYER_FN template <int l> static void
#else
__device__ __forceinline__ constexpr bool probe_dup(int id) {
    if (PROBE_KIND == 0) return false;
    if (id == 0) return PROBE_KIND == 1;
    const int l = (id - 1) / 24, k = (id - 1) % 24;
    if (PROBE_KIND == 2) return k == 17 || k == 19;
    if (PROBE_KIND == 3) return l == 2 && k == 6;
    if (PROBE_KIND == 4) return l == 0 && k == 4;
    if (PROBE_KIND == 5) return (l == 0 && (k == 1 || k == 6)) || (l == 1 && (k == 0 || k == 4)) || (l == 2 && (k == 0 || k == 7));
    if (PROBE_KIND == 7) return (l == 0 && (k == 0 || k == 5)) || (l == 1 && k == 2) || (l == 2 && (k == 2 || k == 3)) || (l == 3 && (k == 0 || k == 1));
    return false;
}
#define PH(id, ...) do { if (ph_lo <= (id) && (id) < ph_hi) { __VA_ARGS__; if (probe_dup(id)) { if (multi) xcd_barrier(bar); __VA_ARGS__; } if (multi) xcd_barrier(bar); if (PROBE_KIND == 8) { xcd_barrier(bar); xcd_barrier(bar); } } } while (0)
typedef Ctx Args;
#define LAYER_ARGS const Ctx& C, int ph_lo, int ph_hi, bool multi, const XcdBarrier& bar, LAS unsigned char* lds
#define LAYER_PASS C, ph_lo, ph_hi, multi, bar, lds
#define LAYER_FN template <int l> __device__ __forceinline__ void
#endif
LAYER_FN layer_program(LAYER_ARGS) {

        const int pb = 1 + l * PH_PER_LAYER;
        if constexpr (l == 0) {
#ifdef HOSTTEST
            PH(pb + 0, PHASE(ph_modx0(C, gt, gs)));
#else
            PH(pb + 0, modx0_fast(C));
#endif
#ifdef HOSTTEST
            PH(pb + 1, { G_Dense g = mk_dense(C.w<bf16>(WS_H), D_, C.f(I_RET_W_IN), D_, RW, nullptr, C.w<bf16>(WS_QKVG), RW); GEMM(g); });
            PH(pb + 2, PHASE(ph_ret_rope(C, gt, gs)));
#else
            PH(pb + 1, { { pg8::DenseSched S; S.init(C.w<bf16>(WS_H), D_ * 2, C.w<bf16>(WS_RWIN), (size_t)256 * D_ * 2, T_, 2048); pg8::EpiRetIn E{C.w<bf16>(WS_QKVG), C.w<float>(WS_COS256), C.w<float>(WS_SIN256)};
                           pg8::GemmP P{D_, D_ * 2, 128}; pg8::gemm8<pg8::EpiRetIn, pg8::DenseSched, true>(lds, P, S, E); }
                         { pg8::DenseSched S; S.init(C.w<bf16>(WS_H), D_ * 2, C.w<bf16>(WS_RWIN) + (size_t)4096 * D_, (size_t)256 * D_ * 2, T_, 2048); pg8::EpiPlain E{C.w<bf16>(WS_QKVG) + 4096, RW, nullptr};
                           pg8::GemmP P{D_, D_ * 2, 128}; pg8::gemm8<pg8::EpiPlain, pg8::DenseSched, true>(lds, P, S, E); }
                         { pg8::DenseSched S; S.init(C.w<bf16>(WS_RWIN) + (size_t)2048 * D_, D_ * 2, C.w<bf16>(WS_H), (size_t)256 * D_ * 2, 2048, T_); pg8::EpiPlain E{C.w<bf16>(WS_VT), T_, nullptr};
                           pg8::GemmP P{D_, D_ * 2, 128}; pg8::gemm8<pg8::EpiPlain, pg8::DenseSched, true>(lds, P, S, E); } });
#endif
#ifdef HOSTTEST
            PH(pb + 3, PHASE(ph_ret_p(C, gt, gs)); PHASE(ph_ret_state(C, gt, gs)));
            PH(pb + 4, PHASE(ph_ret_o(C, gt, gs)));
#else
            PH(pb + 4, ret_core_fast(C, lds));
#endif
#ifdef HOSTTEST
            PH(pb + 5, PHASE(ph_ret_gn(C, gt, gs)));
#else
            PH(pb + 5, ret_gn_fast(C));
#endif
#ifdef HOSTTEST
            PH(pb + 6, { G_Dense g = mk_dense(C.w<bf16>(WS_RA2), RH * RDV, C.f(I_RET_W_OUT), RH * RDV, D_, nullptr, C.w<bf16>(WS_Y), D_); GEMM(g); });
#else
            PH(pb + 6, { pg8::DenseSched S; S.init(C.w<bf16>(WS_RA2), 2048 * 2, C.w<bf16>(WS_RWOUT), (size_t)256 * 2048 * 2, T_, D_); pg8::EpiPlain E{C.w<bf16>(WS_Y), D_, nullptr}; pg8::GemmP P{2048, 2048 * 2, 128}; pg8::gemm8<pg8::EpiPlain, pg8::DenseSched, true>(lds, P, S, E); });
#endif
        } else if constexpr (l == 1) {
#ifdef HOSTTEST
            PH(pb + 0, { G_Dense g = mk_dense(C.w<bf16>(WS_H), D_, C.f(I_CONV_W_PW1), D_, 2 * D_, C.f(I_CONV_B_PW1), C.w<bf16>(WS_CRAW), 2 * D_); GEMM(g); });
            PH(pb + 1, PHASE(ph_conv_glu(C, gt, gs)));
#else
            PH(pb + 0, { pg8::DenseSched S; S.init(C.w<bf16>(WS_H), D_ * 2, C.w<bf16>(WS_CPW1), (size_t)256 * D_ * 2, T_, 2 * D_); pg8::EpiGlu E{C.w<bf16>(WS_CU), C.f(I_CONV_B_PW1)}; pg8::GemmP P{D_, D_ * 2, 128}; pg8::gemm8<pg8::EpiGlu, pg8::DenseSched, true>(lds, P, S, E); });
#endif
#ifdef HOSTTEST
            PH(pb + 2, PHASE(ph_conv_dw(C, gt, gs)));
            PH(pb + 3, PHASE(ph_conv_ln(C, gt, gs)));
#else
            PH(pb + 2, conv_fast(C, lds));
#endif
#ifdef HOSTTEST
            PH(pb + 4, { G_Dense g = mk_dense(C.w<bf16>(WS_CA2), D_, C.f(I_CONV_W_PW2), D_, D_, C.f(I_CONV_B_PW2), C.w<bf16>(WS_Y), D_); GEMM(g); });
#else
            PH(pb + 4, { pg8::DenseSched S; S.init(C.w<bf16>(WS_CA2), D_ * 2, C.w<bf16>(WS_CPW2), (size_t)256 * D_ * 2, T_, D_); pg8::EpiPlain E{C.w<bf16>(WS_Y), D_, C.f(I_CONV_B_PW2)}; pg8::GemmP P{D_, D_ * 2, 128}; pg8::gemm8<pg8::EpiPlain, pg8::DenseSched, true>(lds, P, S, E); });
#endif
        } else if constexpr (l == 2) {
#ifdef HOSTTEST
            PH(pb + 0, { G_NsaIn g; g.Z = 1; g.MT = T_ / 128; g.N = NINW; g.K = D_; g.A = C.w<bf16>(WS_H); g.W = C.f(I_NSA_W_IN); g.Q = C.w<bf16>(WS_NQ); g.KV = C.w<bf16>(WS_NKV);
                         g.GT = C.w<float>(WS_NGT); g.gate_b = C.f(I_NSA_GATE_B); GEMM(g); });
            PH(pb + 1, PHASE(ph_nsa_rope(C, gt, gs)));
            PH(pb + 2, { G_Cmp1 g; g.Z = 2 * NBG; g.MT = 2; g.N = 256; g.K = 2048; g.KV = C.w<bf16>(WS_NKV); g.w1k = C.f(I_NSA_K_W1); g.w1v = C.f(I_NSA_V_W1); g.cb = C.w<float>(WS_CB);
                         g.H = C.w<bf16>(WS_CMPH); GEMM(g); });
#else
            PH(pb + 0, { pg8::DenseSched S; S.init(C.w<bf16>(WS_H), D_ * 2, C.w<bf16>(WS_NWIN), (size_t)256 * D_ * 2, T_, 2048); pg8::EpiNsaIn E{C.w<bf16>(WS_NQ), C.w<bf16>(WS_NKV), C.w<float>(WS_NGT), C.f(I_NSA_GATE_B), C.w<float>(WS_COS64), C.w<float>(WS_SIN64)}; pg8::GemmP P{D_, D_ * 2, 128}; pg8::gemm8<pg8::EpiNsaIn, pg8::DenseSched, true>(lds, P, S, E); });
            PH(pb + 2, { pg8::CmpSched S; S.KV = (const char*)C.w<bf16>(WS_NKV); S.W = (const char*)C.w<bf16>(WS_CW1T); S.G = gridDim.x; S.c = blockIdx.x; pg8::EpiCmp1 E{C.w<bf16>(WS_CMPH), C.w<float>(WS_CB)};
                         pg8::GemmP P{2048, 2048 * 2, NKVW * 2}; pg8::gemm8<pg8::EpiCmp1, pg8::CmpSched, true>(lds, P, S, E); });
#endif
            PH(pb + 3, { G_Cmp2 g; g.Z = 2 * NBG; g.MT = 2; g.N = 64; g.K = 256; g.H = C.w<bf16>(WS_CMPH); g.w2k = C.f(I_NSA_K_W2); g.w2v = C.f(I_NSA_V_W2); g.O = C.w<bf16>(WS_CMPKV); GEMM(g); });
#ifdef HOSTTEST
            PH(pb + 4, PHASE(ph_nsa_cmp_attn(C, gt, gs)));
            PH(pb + 5, PHASE(ph_nsa_select(C, gt, gs)));
            PH(pb + 6, PHASE(ph_nsa_attn(C, gt, gs)));
#else
            PH(pb + 6, nsa_attn_fast(C, lds));
#endif
#ifdef HOSTTEST
            PH(pb + 7, { G_Dense g = mk_dense(C.w<bf16>(WS_NO), D_, C.f(I_NSA_W_OUT), D_, D_, nullptr, C.w<bf16>(WS_Y), D_); GEMM(g); });
#else
            PH(pb + 7, { pg8::DenseSched S; S.init(C.w<bf16>(WS_NO), D_ * 2, C.w<bf16>(WS_NWOUT), (size_t)256 * D_ * 2, T_, D_); pg8::EpiPlain E{C.w<bf16>(WS_Y), D_, nullptr}; pg8::GemmP P{D_, D_ * 2, 128}; pg8::gemm8<pg8::EpiPlain, pg8::DenseSched, true>(lds, P, S, E); });
#endif
        } else {
#ifdef HOSTTEST
            PH(pb + 0, PHASE(ph_pool(C, gt, gs)));
#else
            PH(pb + 0, pool_fast(C, lds));
#endif
#ifdef HOSTTEST
            PH(pb + 1, { G_Pool g; g.Z = 4; g.MT = T_ / 128; g.N = 256; g.K = 256; g.PL = C.w<bf16>(WS_PL); g.W = C.f(I_POOL_W); g.pb = C.f(I_POOL_B); g.ps = C.f(I_POOL_SCALE);
                         g.Y = C.w<bf16>(WS_Y); GEMM(g); });
#else
            PH(pb + 1, { pg8::DenseSched S; S.init(C.w<bf16>(WS_PL), D_ * 2, C.w<bf16>(WS_PWT), (size_t)256 * 256 * 2, T_, D_, 512); pg8::EpiPool E{C.w<bf16>(WS_Y), C.f(I_POOL_B), C.f(I_POOL_SCALE)}; pg8::GemmP P{256, 256 * 2, 128}; pg8::gemm8<pg8::EpiPool, pg8::DenseSched, true>(lds, P, S, E); });
#endif
        }
#ifdef HOSTTEST
        PH(pb + 16, PHASE(ph_ln(C, l, 0, gt, gs)));
#else
        PH(pb + 16, ln_fast<0, false, l == 0, false>(C, l, lds));
#endif
#ifdef HOSTTEST
        PH(pb + 17, { G_MoeUp g; g.Z = NE; g.MT = T_ / 128; g.N = 2 * DFF; g.K = D_; g.Hh = C.w<bf16>(WS_H); g.list = C.w<int>(WS_LIST); g.cnt = C.cnt(l);
                      g.W = C.f(I_MOE_W1) + (size_t)l * NE * D_ * 2 * DFF; g.b1 = C.f(I_MOE_B1) + (size_t)l * NE * 2 * DFF; g.GU = C.w<bf16>(WS_GU); GEMM(g); });
        PH(pb + 18, PHASE(ph_moe_act(C, gt, gs)));
        PH(pb + 19, { G_MoeDown g; g.Z = NE; g.MT = T_ / 128; g.N = D_; g.K = DFF; g.ACT = C.w<bf16>(WS_ACT); g.list = C.w<int>(WS_LIST); g.cnt = C.cnt(l);
                      g.W = C.f(I_MOE_W2) + (size_t)l * NE * DFF * D_; g.b2 = C.f(I_MOE_B2) + (size_t)l * NE * D_; g.YS = C.w<bf16>(WS_YS); GEMM(g); });
#else
        PH(pb + 17, { pg8::MoeSched S; S.cnt = C.cnt(l); S.list = C.w<int>(WS_LIST); S.A0 = (const char*)C.w<unsigned char>(WS_H8); S.B0 = (const char*)C.w<unsigned char>(WS_W1T) + (size_t)l * NE * 2 * DFF * D_;
                      S.b_e_b = (size_t)2 * DFF * D_; S.b_pn_b = (size_t)256 * D_; S.lda_b = D_; S.npn = 8; S.G = gridDim.x; S.c = (blockIdx.x % 8) * (gridDim.x / 8) + blockIdx.x / 8; S.build((LAS int*)(lds + 132096));
                      pg8::EpiMoeUp E{C.f(I_MOE_B1) + (size_t)l * NE * 2 * DFF, C.w<unsigned char>(WS_ACTC)}; pg8::GemmP P{PROBE_KIND == 10 ? D_ : D_ / 2, D_, 128, PROBE_KIND == 10 ? 8 : 0};
                      pg8::gemm8<pg8::EpiMoeUp, pg8::MoeSched, true, true>(lds, P, S, E); });
        PH(pb + 19, { pg8::MoeSchedC S; S.cnt = C.cnt(l); S.list = C.w<int>(WS_LIST); S.A0 = (const char*)C.w<unsigned char>(WS_ACTC); S.B0 = (const char*)C.w<unsigned char>(WS_W2T) + (size_t)l * NE * D_ * DFF;
                      S.b_e_b = (size_t)D_ * DFF; S.b_pn_b = (size_t)256 * DFF; S.lda_b = DFF; S.npn = 4; S.G = gridDim.x; S.c = (blockIdx.x % 8) * (gridDim.x / 8) + blockIdx.x / 8; S.build((LAS int*)(lds + 132096));
                      pg8::EpiMoeDown E{C.f(I_MOE_B2) + (size_t)l * NE * D_, C.w<unsigned char>(WS_YC)}; pg8::GemmP P{PROBE_KIND == 10 ? DFF : DFF / 2, DFF, 128, PROBE_KIND == 10 ? 8 : 0};
                      pg8::gemm8<pg8::EpiMoeDown, pg8::MoeSchedC, true, true>(lds, P, S, E); });
#endif
#ifdef HOSTTEST
        PH(pb + 20, PHASE(ph_ln(C, l, 1, gt, gs)));
#else
        PH(pb + 20, if (PROBE_KIND == 6) { ln_fast<1, true, false, false>(C, l, lds); xcd_barrier(bar); } ln_fast<1, false, false, l == DEPTH - 1>(C, l, lds));
#endif
}
#ifdef HOSTTEST
static void run_phases(const Ctx& C, int ph_lo, int ph_hi)
#else
__global__ void __launch_bounds__(NTHREADS, 2) fwd(const Args C)
#endif
{
#ifndef HOSTTEST
    extern __shared__ __attribute__((aligned(16))) unsigned char lds_raw[];
    LAS unsigned char* lds = (LAS unsigned char*)lds_raw;
    const int ph_lo = C.ph_lo, ph_hi = C.ph_hi; const bool multi = (ph_hi - ph_lo) > 1;
    volatile LAS unsigned* xbst = (volatile LAS unsigned*)(lds + LDS_MISC);
    if (threadIdx.x < 4) xbst[threadIdx.x] = 0u;
    __syncthreads();
    XcdBarrier bar; bar.bar = C.w<unsigned>(WS_CTL) + CW_BAR; bar.x = 0; bar.st = xbst;
    if (multi) bar = xcd_barrier_post(C.w<unsigned>(WS_CTL) + CW_BAR, xbst);
#endif
#ifdef HOSTTEST
    PH(0, PHASE(ph_prologue(C, gt, gs)));
#else
    PH(0, mod_fast(C, lds); cb_fast(C, lds); rope_tables(C); ph_convert_weights(C, lds));
#endif
    layer_program<0>(LAYER_PASS);
    layer_program<1>(LAYER_PASS);
    layer_program<2>(LAYER_PASS);
    layer_program<3>(LAYER_PASS);
}

#ifndef HOSTTEST
static bool phase_used(int id) {
    if (id == 0) return true;
    const int l = (id - 1) / PH_PER_LAYER, k = (id - 1) % PH_PER_LAYER;
    if (k >= 16) return k <= 20;
    const int nmix[4] = {7, 5, 8, 2};
    return k < nmix[l];
}
#ifndef ONE_LAUNCH
#define ONE_LAUNCH 1
#endif
extern "C" void kernel_launch(void* const* d_in, const int* in_sizes, int n_in, void* d_out, int out_size, void* d_ws, size_t ws_size, hipStream_t stream) {
    static int grid = 0;
    if (grid == 0) {
        if (n_in != N_IN || out_size != T_ * D_ || ws_size < WS_END) { fprintf(stderr, "kernel_launch: unexpected shapes (n_in %d out %d ws %zu need %zu)\n", n_in, out_size, ws_size, (size_t)WS_END); grid = -1; return; }
        int dev = 0, cus = 0;
        if (hipGetDevice(&dev) != hipSuccess || hipDeviceGetAttribute(&cus, hipDeviceAttributeMultiprocessorCount, dev) != hipSuccess) { grid = -1; return; }
        if (hipFuncSetAttribute((const void*)fwd, hipFuncAttributeMaxDynamicSharedMemorySize, LDS_BYTES) != hipSuccess) { grid = -1; return; }
        int per_cu = 0;
        if (hipOccupancyMaxActiveBlocksPerMultiprocessor(&per_cu, (const void*)fwd, NTHREADS, LDS_BYTES) != hipSuccess || per_cu < 1) { fprintf(stderr, "kernel_launch: occupancy query says %d\n", per_cu); }
        (void)hipGetLastError();
        if (cus < 256) { fprintf(stderr, "kernel_launch: built for 256 CUs (one resident workgroup each), found %d\n", cus); grid = -1; return; }
        grid = 256;
    }
    if (grid < 0) return;
    (void)in_sizes;
    (void)hipMemsetAsync((char*)d_ws + WS_CTL, 0, CTL_ZERO_BYTES, stream);
    Args a{};
    for (int i = 0; i < N_IN; ++i) a.in[i] = d_in[i];
    a.out = (float*)d_out; a.ws = (unsigned char*)d_ws;
#if ONE_LAUNCH
    a.ph_lo = 0; a.ph_hi = PH_TOTAL;
    hipLaunchKernelGGL(fwd, dim3(grid), dim3(NTHREADS), LDS_BYTES, stream, a);
#else
    for (int id = 0; id < PH_TOTAL; ++id) if (phase_used(id)) { a.ph_lo = id; a.ph_hi = id + 1; hipLaunchKernelGGL(fwd, dim3(grid), dim3(NTHREADS), LDS_BYTES, stream, a); }
#endif
}
#endif
```
